# Optimizing an MI355X kernel written in HIP

```python
import math, functools
import jax, jax.numpy as jnp
from jax import lax
import numpy as np

D_MODEL = 2048
BATCH = 8
SEQ = 2048
DEPTH = 1
DEC_BATCH = 128
DEC_SEQ = 8
PAST_LEN = 8192
PAGE_SIZE = 128

HEAD_DIM = 64
N_Q_HEADS = D_MODEL // HEAD_DIM
N_KV_HEADS = N_Q_HEADS // 8
GQA_GROUP = N_Q_HEADS // N_KV_HEADS
WINDOW = 128
D_Q = N_Q_HEADS * HEAD_DIM
D_KV = N_KV_HEADS * HEAD_DIM
POOL_WINDOWS = (2, 4, 8, 16)
N_POOL_GROUPS = len(POOL_WINDOWS)
D_POOL = D_MODEL // 2
POOL_GROUP = D_POOL // N_POOL_GROUPS
POOL_OUT_GROUP = D_MODEL // N_POOL_GROUPS
POOL_HIST = max(POOL_WINDOWS) - 1
D_IN = D_Q + 2 * D_KV + D_POOL + 2 * D_MODEL
D_FF = 4 * D_MODEL
EPS = 1e-6
NEG_INF = -1e30

kernel_name = "hybrid_swa_sink_pool_gated_decoder_step"


def rmsnorm(x, g):
    xf = x.astype(jnp.float32)
    r = lax.rsqrt(jnp.mean(xf * xf, axis=-1, keepdims=True) + EPS)
    return (xf * r * g.astype(jnp.float32)).astype(x.dtype)


def split_proj(h, w_in):
    B, T, _ = h.shape
    z = jnp.einsum('btd,de->bte', h, w_in)
    c = np.cumsum([D_Q, D_KV, D_KV, D_POOL, D_MODEL])
    q, k, v, u, ga, gp = jnp.split(z, list(c), axis=-1)
    q = q.reshape(B, T, N_KV_HEADS, GQA_GROUP, HEAD_DIM)
    k = k.reshape(B, T, N_KV_HEADS, HEAD_DIM)
    v = v.reshape(B, T, N_KV_HEADS, HEAD_DIM)
    return q, k, v, u, ga, gp


def sink_softmax(s, mask, sinks):
    s = jnp.where(mask, s, NEG_INF)
    sk = sinks.astype(jnp.float32)[:, :, None]
    m = jnp.maximum(jnp.max(s, axis=-1), sk)
    p = jnp.exp(s - m[..., None])
    denom = jnp.sum(p, axis=-1) + jnp.exp(sk - m)
    return p / denom[..., None]


def window_attn_prompt(q, k, v, sinks):
    B, S = q.shape[:2]
    nb = S // WINDOW
    scale = HEAD_DIM ** -0.5
    qb = q.reshape(B, nb, WINDOW, N_KV_HEADS, GQA_GROUP, HEAD_DIM)
    kc = k.reshape(B, nb, WINDOW, N_KV_HEADS, HEAD_DIM)
    vc = v.reshape(B, nb, WINDOW, N_KV_HEADS, HEAD_DIM)
    kb = jnp.concatenate([jnp.concatenate([jnp.zeros_like(kc[:, :1]), kc[:, :-1]], 1), kc], axis=2)
    vb = jnp.concatenate([jnp.concatenate([jnp.zeros_like(vc[:, :1]), vc[:, :-1]], 1), vc], axis=2)
    s = jnp.einsum('bnqhgd,bnkhd->bnhgqk', qb.astype(jnp.float32), kb.astype(jnp.float32)) * scale
    i = jnp.arange(WINDOW)[:, None] + WINDOW
    j = jnp.arange(2 * WINDOW)[None, :]
    rel = i - j
    band = (rel >= 0) & (rel < WINDOW)
    has_prev = (jnp.arange(nb)[:, None, None] > 0) | (j >= WINDOW)[None]
    mask = (band[None] & has_prev)[None, :, None, None]
    probs = sink_softmax(s, mask, sinks)
    out = jnp.einsum('bnhgqk,bnkhd->bnqhgd', probs, vb.astype(jnp.float32))
    wb = min(WINDOW, S)
    return out.reshape(B, S, D_Q).astype(q.dtype), k[:, S - wb:], v[:, S - wb:]


def window_attn_sample(q, k, v, k_hist, v_hist, sinks):
    B, T = q.shape[:2]
    wb = k_hist.shape[1]
    scale = HEAD_DIM ** -0.5
    k_ext = jnp.concatenate([k_hist, k.astype(k_hist.dtype)], axis=1)
    v_ext = jnp.concatenate([v_hist, v.astype(v_hist.dtype)], axis=1)
    s = jnp.einsum('bqhgd,bkhd->bhgqk', q.astype(jnp.float32), k_ext.astype(jnp.float32)) * scale
    rel = (wb + jnp.arange(T))[:, None] - jnp.arange(wb + T)[None, :]
    mask = ((rel >= 0) & (rel < WINDOW))[None, None, None]
    probs = sink_softmax(s, mask, sinks)
    out = jnp.einsum('bhgqk,bkhd->bqhgd', probs, v_ext.astype(jnp.float32))
    return out.reshape(B, T, D_Q).astype(q.dtype), k_ext[:, T:], v_ext[:, T:]


def pool_branch(u_hist, u, pos0, w_pool, pool_scale):
    B, T, _ = u.shape
    P = u_hist.shape[1]
    u_ext = jnp.concatenate([u_hist.astype(u.dtype), u], axis=1)
    uf = u_ext.astype(jnp.float32)
    cs = jnp.concatenate([jnp.zeros((B, 1, D_POOL), jnp.float32), jnp.cumsum(uf, axis=1)], axis=1)
    end = P + jnp.arange(T) + 1
    pos = pos0 + jnp.arange(T)
    u_new = uf[:, P:]
    outs = []
    for g, w in enumerate(POOL_WINDOWS):
        sl = slice(g * POOL_GROUP, (g + 1) * POOL_GROUP)
        wsum = cs[:, end, sl] - cs[:, end - w, sl]
        cnt = jnp.minimum(pos + 1, w).astype(jnp.float32)[None, :, None]
        pooled = wsum / cnt - u_new[:, :, sl]
        outs.append(jnp.einsum('btc,cd->btd', pooled, w_pool[g].astype(jnp.float32)))
    p = jnp.concatenate(outs, axis=-1) * pool_scale.astype(jnp.float32)
    return p.astype(u.dtype), u_ext[:, P + T - POOL_HIST:]


def decoder_layer(x, attn_fn, u_hist, pos0, norm_attn_pre, norm_attn_post, w_in, w_pool,
                  pool_scale, w_out, norm_mlp_pre, norm_mlp_post, w_up, w_down):
    h = rmsnorm(x, norm_attn_pre)
    q, k, v, u, ga, gp = split_proj(h, w_in)
    a, k_state, v_state = attn_fn(q, k, v)
    p, u_state = pool_branch(u_hist, u, pos0, w_pool, pool_scale)
    mixed = jax.nn.sigmoid(ga) * a + jax.nn.sigmoid(gp) * p
    x = x + rmsnorm(jnp.einsum('btd,de->bte', mixed, w_out), norm_attn_post)
    h2 = rmsnorm(x, norm_mlp_pre)
    f = jnp.einsum('btf,fd->btd', jnp.square(jax.nn.relu(jnp.einsum('btd,df->btf', h2, w_up))), w_down)
    x = x + rmsnorm(f, norm_mlp_post)
    return x, k_state, v_state, u_state


def setup_inputs(seed: int = 0) -> dict:
    key = jax.random.key(seed)
    ks = jax.random.split(key, 16)
    wb = min(WINDOW, PAST_LEN)
    f32 = jnp.float32
    nrm = lambda k, shape, s: jax.random.normal(k, shape, f32) * s
    return {
        "x_prompt": nrm(ks[0], (BATCH, SEQ, D_MODEL), 1.0),
        "x_sample": nrm(ks[1], (DEC_BATCH, DEC_SEQ, D_MODEL), 1.0),
        "cache_k_win": nrm(ks[2], (DEPTH, DEC_BATCH, wb, N_KV_HEADS, HEAD_DIM), 1.0),
        "cache_v_win": nrm(ks[3], (DEPTH, DEC_BATCH, wb, N_KV_HEADS, HEAD_DIM), 1.0),
        "state_pool": nrm(ks[4], (DEPTH, DEC_BATCH, POOL_HIST, D_POOL), 1.0),
        "norm_attn_pre": 1.0 + nrm(ks[5], (DEPTH, D_MODEL), 0.02),
        "norm_attn_post": 1.0 + nrm(ks[6], (DEPTH, D_MODEL), 0.02),
        "w_in": nrm(ks[7], (DEPTH, D_MODEL, D_IN), D_MODEL ** -0.5),
        "attn_sinks": nrm(ks[8], (DEPTH, N_KV_HEADS, GQA_GROUP), 0.5),
        "w_pool": nrm(ks[9], (DEPTH, N_POOL_GROUPS, POOL_GROUP, POOL_OUT_GROUP), POOL_GROUP ** -0.5),
        "pool_scale": 1.0 + nrm(ks[10], (DEPTH, D_MODEL), 0.1),
        "w_out": nrm(ks[11], (DEPTH, D_MODEL, D_MODEL), D_MODEL ** -0.5),
        "norm_mlp_pre": 1.0 + nrm(ks[12], (DEPTH, D_MODEL), 0.02),
        "norm_mlp_post": 1.0 + nrm(ks[13], (DEPTH, D_MODEL), 0.02),
        "w_up": nrm(ks[14], (DEPTH, D_MODEL, D_FF), D_MODEL ** -0.5),
        "w_down": nrm(ks[15], (DEPTH, D_FF, D_MODEL), D_FF ** -0.5),
    }


def reference(x_prompt, x_sample, cache_k_win, cache_v_win, state_pool, norm_attn_pre,
              norm_attn_post, w_in, attn_sinks, w_pool, pool_scale, w_out, norm_mlp_pre,
              norm_mlp_post, w_up, w_down):
    xp, xs = x_prompt, x_sample
    kp_l, vp_l, up_l, ks_l, vs_l, us_l = [], [], [], [], [], []
    for l in range(DEPTH):
        params = (norm_attn_pre[l], norm_attn_post[l], w_in[l], w_pool[l], pool_scale[l],
                  w_out[l], norm_mlp_pre[l], norm_mlp_post[l], w_up[l], w_down[l])
        u0 = jnp.zeros((xp.shape[0], POOL_HIST, D_POOL), xp.dtype)
        attn_p = functools.partial(window_attn_prompt, sinks=attn_sinks[l])
        xp, kp, vp, up = decoder_layer(xp, attn_p, u0, 0, *params)
        attn_s = functools.partial(window_attn_sample, k_hist=cache_k_win[l],
                                   v_hist=cache_v_win[l], sinks=attn_sinks[l])
        xs, kss, vss, uss = decoder_layer(xs, attn_s, state_pool[l], PAST_LEN, *params)
        kp_l.append(kp); vp_l.append(vp); up_l.append(up)
        ks_l.append(kss); vs_l.append(vss); us_l.append(uss)
    y_prompt, y_sample = xp, xs
    return (y_prompt, y_sample, jnp.stack(kp_l), jnp.stack(vp_l), jnp.stack(up_l),
            jnp.stack(ks_l), jnp.stack(vs_l), jnp.stack(us_l))
```

```cpp
#include <hip/hip_runtime.h>
#include <hip/hip_cooperative_groups.h>
#include <cstdio>
#include <cstdint>
namespace cg = cooperative_groups;

#ifndef MK_N_LAUNCHES
#define MK_N_LAUNCHES 1
#endif
constexpr int N_PHASES = 9;
#ifndef PROBE_P2A
#define PROBE_P2A 1
#endif
#ifndef PROBE_P2C
#define PROBE_P2C 1
#endif
#ifndef PROBE_P2D
#define PROBE_P2D 1
#endif
#ifndef PROBE_DBLBAR
#define PROBE_DBLBAR 0
#endif
#ifndef PROBE_P2B
#define PROBE_P2B 1
#endif
#ifndef PROBE_REPEAT_MASK
#define PROBE_REPEAT_MASK 0
#endif

constexpr int DM = 2048, NPR = 16384, NSR = 1024, MROWS = NPR + NSR;
constexpr int DIN = 7680, DFF = 8192, DPOOL = 1024;
constexpr int KOFF = 2048, VOFF = 2304, UOFF = 2560, GAOFF = 3584, GPOFF = 5632;
constexpr float EPS = 1e-6f;
constexpr size_t G8_BYTE_OFF = (size_t)56 * 17408 * 128;
__host__ __device__ __forceinline__ size_t g8off(size_t row, int gcol) { return ((size_t)(gcol >> 6) * 17408 + row) * 64 + (size_t)(gcol & 63); }
__host__ __device__ __forceinline__ size_t zoff(size_t row, int col) { return ((size_t)(col >> 6) * 17408 + row) * 64 + (size_t)(col & 63); }
constexpr size_t O_YP = 0, O_KP = 35651584, O_VP = 35913728, O_PP = 36175872, O_KS = 36298752, O_VS = 40493056, O_PS = 44687360, O_END = 46653440;
constexpr size_t MiB = 1u << 20;
constexpr size_t WS_WIN = 1 * MiB, WS_WOUT = 31 * MiB, WS_WUP = 39 * MiB, WS_WDN = 71 * MiB, WS_WPOOL = 103 * MiB;
constexpr size_t WS_XN = 104 * MiB;
constexpr size_t WS_R = 172 * MiB;
constexpr size_t WS_POOLED = 427 * MiB;
constexpr size_t WS_W8 = 17 * MiB;
constexpr int NBF = 3584, NF8 = 4096;
constexpr size_t WS_SP = 444 * MiB, WS_END = 508 * MiB;
constexpr int KSPLIT = 8, TAILP = 4;

#define GAS __attribute__((address_space(1)))
#define LAS __attribute__((address_space(3)))

namespace pg8 {
typedef unsigned short bf16_t;
typedef short bf16x8 __attribute__((ext_vector_type(8)));
typedef float f32x4 __attribute__((ext_vector_type(4)));
typedef unsigned u32x4 __attribute__((ext_vector_type(4)));
typedef int i32x4 __attribute__((ext_vector_type(4)));
constexpr int BM = 256, BK = 64, HALF = 128, HTB = HALF * BK * 2, STAGE_BYTES = 8 * HTB, NXCD = 8, WGM = 8;

__host__ __device__ __forceinline__ int lds_byte(int r, int c) { const int st = (r >> 4) * 2 + (c >> 5), rr = r & 15, cc = c & 31, ob = rr * 64 + cc * 2; return st * 1024 + (ob ^ (((ob >> 9) & 1) << 5)); }
__host__ __device__ __forceinline__ void stage_rc(int b, int& R, int& C) { const int st = b / 1024, sb = b % 1024, swz = sb ^ (((sb >> 9) & 1) << 5); R = (st >> 1) * 16 + swz / 64; C = (st & 1) * 32 + (swz % 64) / 2; }
__host__ __device__ __forceinline__ int perm32(int rho) { const int n = rho >> 4, i = rho & 15; return 8 * (i >> 2) + 4 * n + (i & 3); }

struct Unit { int pm, pn, ks, hb; };
struct Gemm { const bf16_t* A; const bf16_t* Bt; int M, N, K, lda, ldb, ag_shift, ag_bytes; };

struct StaticOrder {
    int nM, nN, nwg, G, c, nMf, nfull, ksplit, hs0, base, limit;
    __host__ __device__ void init(int M, int N, int G_, int c_, int tail = 0, int ksplit_ = 1, int hs0_ = -1) { nM = M / BM; nN = N / BM; nMf = nM - tail; nfull = nMf * nN; ksplit = ksplit_;
        hs0 = hs0_ < 0 ? nfull : hs0_; nwg = hs0 + 2 * (nfull - hs0) + tail * nN * ksplit_; G = G_; c = c_; base = 0; limit = nwg; }
    __host__ __device__ bool next(int i, Unit& u) const {
        const long L = base + (long)i * G + c; if (L >= limit) return false;
        const int nfl = hs0 + 2 * (nfull - hs0);
        const bool tl = L >= nfl;
        const int Lp = (int)L - nfl, idx = Lp / ksplit;
        const bool hf = !tl && L >= hs0;
        int wgid = tl ? 0 : (hf ? hs0 + (((int)L - hs0) >> 1) : (int)L);
        { const int q = nfull / NXCD, r = nfull % NXCD, xcd = wgid % NXCD, off = wgid / NXCD; wgid = (xcd < r ? xcd * (q + 1) : r * (q + 1) + (xcd - r) * q) + off; }
        const int nig = WGM * nN, gid = wgid / nig, fm = gid * WGM, gsz = (nMf - fm) < WGM ? (nMf - fm) : WGM;
        const int pm = tl ? nMf + idx / nN : fm + ((wgid % nig) % gsz), pn = tl ? idx % nN : (wgid % nig) / gsz, ks = tl ? Lp % ksplit : -1, hb = hf ? (((int)L - hs0) & 1) : -1;
        u.pm = pm; u.pn = pn; u.ks = ks; u.hb = hb; return true;
    }
};

__device__ __forceinline__ unsigned cvt_pk_bf16(float lo, float hi) { unsigned r; asm volatile("v_cvt_pk_bf16_f32 %0, %1, %2" : "=v"(r) : "v"(lo), "v"(hi)); return r; }
__device__ __forceinline__ float bf_lo(unsigned w) { return __uint_as_float(w << 16); }
__device__ __forceinline__ float bf_hi(unsigned w) { return __uint_as_float(w & 0xffff0000u); }
__device__ __forceinline__ float sigmoidf_(float x) { return __builtin_amdgcn_rcpf(1.0f + __builtin_amdgcn_exp2f(-1.4426950408889634f * x)); }

template <int ACT  > struct EpiBf16 {
    static constexpr bool PERM = true;
    bf16_t* O; int ldc; float* SP; int sp_row0;
    float sc = 1.0f;
    int cg0 = -1;
    __device__ __forceinline__ void partial(const f32x4 (&acc)[2][2][4][2], const Unit& u, int wr, int wc, int fr, int fq) const {
        const int row0 = u.pm * BM + wr * 64 + fr - sp_row0 + u.ks * 1024; const int col0 = u.pn * BM + wc * 32 + 8 * fq;
#pragma unroll
        for (int ai = 0; ai < 2; ++ai)
#pragma unroll
            for (int m = 0; m < 4; ++m) { bf16_t* rowp = (bf16_t*)SP + (size_t)(row0 + ai * HALF + m * 16) * ldc + col0;
#pragma unroll
                for (int bj = 0; bj < 2; ++bj) { const f32x4 v0 = acc[ai][bj][m][0], v1 = acc[ai][bj][m][1];
                    typedef float f2_ __attribute__((ext_vector_type(2))); typedef __bf16 b2_ __attribute__((ext_vector_type(2)));
                    u32x4 w; w.x = __builtin_bit_cast(unsigned, __builtin_convertvector((f2_){v0[0], v0[1]}, b2_)); w.y = __builtin_bit_cast(unsigned, __builtin_convertvector((f2_){v0[2], v0[3]}, b2_));
                    w.z = __builtin_bit_cast(unsigned, __builtin_convertvector((f2_){v1[0], v1[1]}, b2_)); w.w = __builtin_bit_cast(unsigned, __builtin_convertvector((f2_){v1[2], v1[3]}, b2_));
                    *(u32x4*)(rowp + bj * HALF) = w; asm volatile("; split-K partial tile" ::: "memory"); } }
    }
    __device__ __forceinline__ void operator()(const f32x4 (&acc)[2][2][4][2], const Unit& u, int wr, int wc, int fr, int fq) const {
        const int row0 = u.pm * BM + wr * 64 + fr; const int col0 = u.pn * BM + wc * 32 + 8 * fq;
#pragma unroll
        for (int ai = 0; ai < 2; ++ai)
#pragma unroll
            for (int m = 0; m < 4; ++m) { bf16_t* rowp = O + (size_t)(row0 + ai * HALF + m * 16) * ldc + col0;
#pragma unroll
                for (int bj = 0; bj < 2; ++bj) { if (u.hb >= 0 && u.hb != bj) continue;
                    if (cg0 >= 0) rowp = O + zoff((size_t)(row0 + ai * HALF + m * 16), cg0 + col0 + bj * HALF) - bj * HALF; f32x4 v0 = acc[ai][bj][m][0], v1 = acc[ai][bj][m][1];
                    if (ACT == 2) {
#pragma unroll
                        for (int e = 0; e < 4; ++e) { const float a = fmaxf(v0[e], 0.f), b = fmaxf(v1[e], 0.f); v0[e] = a * a; v1[e] = b * b; } }
                    v0 = v0 * sc; v1 = v1 * sc;
                    u32x4 w; w.x = cvt_pk_bf16(v0[0], v0[1]); w.y = cvt_pk_bf16(v0[2], v0[3]); w.z = cvt_pk_bf16(v1[0], v1[1]); w.w = cvt_pk_bf16(v1[2], v1[3]);
                    if (ACT == 2) __builtin_nontemporal_store(w, (u32x4*)(rowp + bj * HALF)); else *(u32x4*)(rowp + bj * HALF) = w; } }
    }
};
struct EpiGate8 {
    static constexpr bool PERM = true;
    unsigned char* G; float sc;
    __device__ __forceinline__ void partial(const f32x4 (&)[2][2][4][2], const Unit&, int, int, int, int) const {}
    __device__ __forceinline__ void operator()(const f32x4 (&acc)[2][2][4][2], const Unit& u, int wr, int wc, int fr, int fq) const {
        const int row0 = u.pm * BM + wr * 64 + fr; const int col0 = u.pn * BM + wc * 32 + 8 * fq;
#pragma unroll
        for (int ai = 0; ai < 2; ++ai)
#pragma unroll
            for (int m = 0; m < 4; ++m)
#pragma unroll
                for (int bj = 0; bj < 2; ++bj) { const f32x4 v0 = acc[ai][bj][m][0] * sc, v1 = acc[ai][bj][m][1] * sc;
                    unsigned q[8];
#pragma unroll
                    for (int e = 0; e < 4; ++e) { q[e] = (unsigned)(sigmoidf_(v0[e]) * 255.0f + 0.5f); q[4 + e] = (unsigned)(sigmoidf_(v1[e]) * 255.0f + 0.5f); }
                    typedef unsigned u32x2 __attribute__((ext_vector_type(2)));
                    u32x2 w; w.x = q[0] | (q[1] << 8) | (q[2] << 16) | (q[3] << 24); w.y = q[4] | (q[5] << 8) | (q[6] << 16) | (q[7] << 24);
                    *(u32x2*)(G + g8off((size_t)(row0 + ai * HALF + m * 16), col0 + bj * HALF)) = w; }
    }
};
struct EpiPool {
    static constexpr bool PERM = true;
    bf16_t* MX; const bf16_t* Z; const float* ps;
    __device__ __forceinline__ void partial(const f32x4 (&)[2][2][4][2], const Unit&, int, int, int, int) const {}
    __device__ __forceinline__ void operator()(const f32x4 (&acc)[2][2][4][2], const Unit& u, int wr, int wc, int fr, int fq) const {
        const int row0 = u.pm * BM + wr * 64 + fr; const int col0 = u.pn * BM + wc * 32 + 8 * fq;
        f32x4 sc[2][2];
#pragma unroll
        for (int bj = 0; bj < 2; ++bj) { sc[bj][0] = *(const f32x4*)(ps + col0 + bj * HALF); sc[bj][1] = *(const f32x4*)(ps + col0 + bj * HALF + 4); }
        unsigned om = (unsigned)(row0 * DM + col0) * 2u, oz = (unsigned)(row0 * DIN + GPOFF + col0) * 2u;
#pragma unroll
        for (int ai = 0; ai < 2; ++ai) {
#pragma unroll
            for (int m = 0; m < 4; ++m) {
#pragma unroll
                for (int bj = 0; bj < 2; ++bj) {
                    char* mp = (char*)MX + om + bj * (HALF * 2); const u32x4 ag = *(const u32x4*)mp; const u32x4 gp = *(const u32x4*)((const char*)Z + oz + bj * (HALF * 2));
                    const f32x4 v0 = acc[ai][bj][m][0] * sc[bj][0], v1 = acc[ai][bj][m][1] * sc[bj][1];
                    u32x4 w;
                    w.x = cvt_pk_bf16(bf_lo(ag.x) + sigmoidf_(bf_lo(gp.x)) * v0[0], bf_hi(ag.x) + sigmoidf_(bf_hi(gp.x)) * v0[1]);
                    w.y = cvt_pk_bf16(bf_lo(ag.y) + sigmoidf_(bf_lo(gp.y)) * v0[2], bf_hi(ag.y) + sigmoidf_(bf_hi(gp.y)) * v0[3]);
                    w.z = cvt_pk_bf16(bf_lo(ag.z) + sigmoidf_(bf_lo(gp.z)) * v1[0], bf_hi(ag.z) + sigmoidf_(bf_hi(gp.z)) * v1[1]);
                    w.w = cvt_pk_bf16(bf_lo(ag.w) + sigmoidf_(bf_lo(gp.w)) * v1[2], bf_hi(ag.w) + sigmoidf_(bf_hi(gp.w)) * v1[3]);
                    *(u32x4*)mp = w; }
                om += 16u * DM * 2u; oz += 16u * DIN * 2u; asm volatile("" : "+v"(om), "+v"(oz) :: "memory"); }
            om += 64u * DM * 2u; oz += 64u * DIN * 2u; }
    }
};

template <class Epi, bool ALIGN_EPI = true, int HB = -1, bool FP8 = false>
__device__ __forceinline__ void gemm_phase(LAS unsigned char* lds, const Gemm g, const StaticOrder& S, const Epi& E) {
    int tid = threadIdx.x; asm volatile("" : "+v"(tid));
    const int wid = __builtin_amdgcn_readfirstlane(tid >> 6), lane = tid & 63, wr = wid >> 2, wc = wid & 3, fr = lane & 15, fq = lane >> 4;
    int nt_full = g.K / BK; asm volatile("" : "+s"(nt_full));
    const int nt_split = nt_full / S.ksplit;
    unsigned voffA[2], voffB[2];
#pragma unroll
    for (int i = 0; i < 2; ++i) { int R, C; stage_rc(tid * 16 + i * 8192, R, C); const int Rb = Epi::PERM ? ((R & ~31) + perm32(R & 31)) : R;
        voffA[i] = (unsigned)(R * g.lda + C) * 2u; voffB[i] = (unsigned)(Rb * g.ldb + C) * 2u; }
    const size_t kstep = (size_t)(BK * 2);
    const size_t hstepA = (size_t)HALF * g.lda * 2, hstepB = (size_t)HALF * g.ldb * 2;
    const size_t tstepA = 2 * hstepA, tstepB = 2 * hstepB;
    const unsigned ldsw = (unsigned)wid * 1024u;
    const int aoff = lds_byte(wr * 64 + fr, fq * 8), boff = lds_byte(wc * 32 + fr, fq * 8);
#define PG8_SA(b, h) (((b) * 2 + (h)) * HTB)
#define PG8_SB(b, h) ((4 + (b) * 2 + (h)) * HTB)
#define PG8_STAGE(bufoff, gbase, voff) do { _Pragma("unroll") for (int _i = 0; _i < 2; ++_i) \
        __builtin_amdgcn_global_load_lds((const unsigned*)((const char*)(gbase) + (voff)[_i]), (LAS unsigned*)(lds + (bufoff) + ldsw + _i * 8192), 16, 0, 0); } while (0)
#define PG8_LDA(dst, b, h) do { _Pragma("unroll") for (int m = 0; m < 4; ++m) _Pragma("unroll") for (int k = 0; k < 2; ++k) dst[m][k] = *(const LAS bf16x8*)(lds + PG8_SA(b, h) + aoff + m * 2048 + k * 1024); } while (0)
#define PG8_LDB(dst, b, h) do { _Pragma("unroll") for (int n = 0; n < 2; ++n) _Pragma("unroll") for (int k = 0; k < 2; ++k) dst[n][k] = *(const LAS bf16x8*)(lds + PG8_SB(b, h) + boff + n * 2048 + k * 1024); } while (0)
#define PG8_CAT(x0, x1) __builtin_shufflevector(__builtin_bit_cast(i32x4, x0), __builtin_bit_cast(i32x4, x1), 0, 1, 2, 3, 4, 5, 6, 7)
#define PG8_MMA(ai, bj, At, Bt) do { __builtin_amdgcn_s_setprio(1); _Pragma("unroll") for (int m = 0; m < 4; ++m) _Pragma("unroll") for (int n = 0; n < 2; ++n) { \
        if constexpr (FP8) { asm volatile("v_mfma_scale_f32_16x16x128_f8f6f4 %0, %1, %2, %0, %3, %3 op_sel_hi:[0,0,0]" : "+v"(acc[ai][bj][m][n]) : "v"(PG8_CAT(Bt[n][0], Bt[n][1])), "v"(PG8_CAT(At[m][0], At[m][1])), "v"(sc127)); } \
        else { _Pragma("unroll") for (int k = 0; k < 2; ++k) acc[ai][bj][m][n] = __builtin_amdgcn_mfma_f32_16x16x32_bf16(Bt[n][k], At[m][k], acc[ai][bj][m][n], 0, 0, 0); } } \
        __builtin_amdgcn_s_setprio(0); } while (0)
#define PG8_WAIT_V(n) asm volatile("s_waitcnt vmcnt(" #n ")" ::: "memory")
#define PG8_WAIT_L(n) asm volatile("s_waitcnt lgkmcnt(" #n ")" ::: "memory")
#define PG8_BAR __builtin_amdgcn_s_barrier()
#define PG8_SCHED __builtin_amdgcn_sched_barrier(0)
#define PG8_KO(u) ((u).ks < 0 ? (size_t)0 : (size_t)((u).ks * nt_split) * kstep)
#define PG8_UA(u) ((const char*)g.A + (size_t)(u).pm * tstepA + (size_t)((u).pn >> g.ag_shift) * (size_t)g.ag_bytes + PG8_KO(u))
#define PG8_UB(u) ((const char*)g.Bt + (size_t)(u).pn * tstepB + PG8_KO(u))
    Unit cur, nxt; int ui = 0;
    if (!S.next(0, cur)) return;
    const int sc127 = 127;
    f32x4 acc[2][2][4][2];
#pragma unroll
    for (int a = 0; a < 2; ++a)
#pragma unroll
        for (int b = 0; b < 2; ++b)
#pragma unroll
            for (int m = 0; m < 4; ++m)
#pragma unroll
                for (int n = 0; n < 2; ++n) acc[a][b][m][n] = (f32x4){0.f, 0.f, 0.f, 0.f};
    bf16x8 At[4][2], B0[2][2], B1[2][2];
    const char* cA = PG8_UA(cur); const char* cB = PG8_UB(cur); int nt = cur.ks < 0 ? nt_full : nt_split;
    PG8_STAGE(PG8_SB(0, 0), cB, voffB); PG8_STAGE(PG8_SB(0, 1), cB + hstepB, voffB); PG8_STAGE(PG8_SA(0, 0), cA, voffA); PG8_STAGE(PG8_SA(0, 1), cA + hstepA, voffA);
    if (wr == 1) PG8_BAR;
    PG8_WAIT_V(2); PG8_BAR;
    PG8_STAGE(PG8_SB(1, 0), cB + kstep, voffB); PG8_STAGE(PG8_SA(1, 0), cA + kstep, voffA); PG8_STAGE(PG8_SB(1, 1), cB + hstepB + kstep, voffB);
    PG8_WAIT_V(6); PG8_BAR;
    for (;;) {
        const bool has_next = S.next(ui + 1, nxt);
        const char* nA = has_next ? PG8_UA(nxt) : cA; const char* nB = has_next ? PG8_UB(nxt) : cB;
        for (int t = 0; t < nt; t += 2) {
            const bool last = (t == nt - 2);
            const char* a1 = cA + (size_t)(t + 1) * kstep;
            const char* a2 = last ? nA : cA + (size_t)(t + 2) * kstep; const char* b2 = last ? nB : cB + (size_t)(t + 2) * kstep;
            const char* a3 = a2 + kstep; const char* b3 = b2 + kstep;
            PG8_LDB(B0, 0, 0); PG8_LDB(B1, 0, 1); PG8_SCHED; PG8_LDA(At, 0, 0); PG8_STAGE(PG8_SA(1, 1), a1 + hstepA, voffA);
            PG8_WAIT_V(8); PG8_WAIT_L(0); PG8_BAR; if constexpr (HB != 1) PG8_MMA(0, 0, At, B0); if constexpr (HB != 0) PG8_MMA(0, 1, At, B1); PG8_BAR; PG8_SCHED;
            PG8_LDA(At, 0, 1); PG8_STAGE(PG8_SB(0, 0), b2, voffB); PG8_STAGE(PG8_SB(0, 1), b2 + hstepB, voffB); PG8_STAGE(PG8_SA(0, 0), a2, voffA);
            PG8_WAIT_V(8); PG8_WAIT_L(0); PG8_BAR; if constexpr (HB != 1) PG8_MMA(1, 0, At, B0); if constexpr (HB != 0) PG8_MMA(1, 1, At, B1); PG8_BAR; PG8_SCHED;
            PG8_LDB(B0, 1, 0); PG8_LDB(B1, 1, 1); PG8_SCHED; PG8_LDA(At, 1, 0); PG8_STAGE(PG8_SA(0, 1), a2 + hstepA, voffA);
            PG8_WAIT_V(8); PG8_WAIT_L(0); PG8_BAR; if constexpr (HB != 1) PG8_MMA(0, 0, At, B0); if constexpr (HB != 0) PG8_MMA(0, 1, At, B1); PG8_BAR; PG8_SCHED;
            PG8_LDA(At, 1, 1); PG8_STAGE(PG8_SB(1, 0), b3, voffB); PG8_STAGE(PG8_SB(1, 1), b3 + hstepB, voffB); PG8_STAGE(PG8_SA(1, 0), a3, voffA);
            PG8_WAIT_V(8); PG8_WAIT_L(0); PG8_BAR; if constexpr (HB != 1) PG8_MMA(1, 0, At, B0); if constexpr (HB != 0) PG8_MMA(1, 1, At, B1); PG8_BAR; PG8_SCHED;
        }
        if constexpr (ALIGN_EPI) { if (wr == 0) PG8_BAR; }
        if constexpr (FP8) asm volatile("s_nop 15\n\ts_nop 15" ::: "memory");
        if (cur.ks < 0) E(acc, cur, wr, wc, fr, fq); else E.partial(acc, cur, wr, wc, fr, fq);
        if (!has_next) break;
#pragma unroll
        for (int a = 0; a < 2; ++a)
#pragma unroll
            for (int b = 0; b < 2; ++b)
#pragma unroll
                for (int m = 0; m < 4; ++m)
#pragma unroll
                    for (int n = 0; n < 2; ++n) acc[a][b][m][n] = (f32x4){0.f, 0.f, 0.f, 0.f};
        cur = nxt; cA = nA; cB = nB; ++ui; nt = cur.ks < 0 ? nt_full : nt_split;
        if constexpr (ALIGN_EPI) { if (wr == 1) PG8_BAR; }
    }
    PG8_WAIT_V(0);
    if constexpr (!ALIGN_EPI) { if (wr == 0) PG8_BAR; }
    PG8_BAR;
#undef PG8_SA
#undef PG8_SB
#undef PG8_STAGE
#undef PG8_LDA
#undef PG8_LDB
#undef PG8_MMA
#undef PG8_CAT
#undef PG8_WAIT_V
#undef PG8_WAIT_L
#undef PG8_BAR
#undef PG8_SCHED
#undef PG8_UA
#undef PG8_KO
#undef PG8_UB
}
}

typedef unsigned short bf16;
typedef unsigned v4u __attribute__((ext_vector_type(4)));
typedef unsigned v2u __attribute__((ext_vector_type(2)));
typedef float f32x4 __attribute__((ext_vector_type(4)));
typedef float f32x16 __attribute__((ext_vector_type(16)));
typedef short bf16x8 __attribute__((ext_vector_type(8)));
typedef short s16x4 __attribute__((ext_vector_type(4)));
#define LDS_WAIT() asm volatile("s_waitcnt lgkmcnt(0)" ::: "memory")
__device__ __forceinline__ unsigned f2bf(float f) { unsigned u = __builtin_bit_cast(unsigned, f); return (u + 0x7fffu + ((u >> 16) & 1u)) >> 16; }
typedef float f32x2_t __attribute__((ext_vector_type(2))); typedef __bf16 bf16x2_t __attribute__((ext_vector_type(2)));
__device__ __forceinline__ unsigned pk2(float lo, float hi) { f32x2_t v = {lo, hi}; bf16x2_t b = __builtin_convertvector(v, bf16x2_t); return __builtin_bit_cast(unsigned, b); }
__device__ __forceinline__ float bflo(unsigned w) { return __uint_as_float(w << 16); }
__device__ __forceinline__ float bfhi(unsigned w) { return __uint_as_float(w & 0xffff0000u); }
__device__ __forceinline__ float dpp_f(float v, const int ctrl_sel) {
    const int x = __float_as_int(v);
    int r;
    if (ctrl_sel == 0) r = __builtin_amdgcn_update_dpp(x, x, 0xB1, 0xF, 0xF, false);
    else if (ctrl_sel == 1) r = __builtin_amdgcn_update_dpp(x, x, 0x4E, 0xF, 0xF, false);
    else if (ctrl_sel == 2) r = __builtin_amdgcn_update_dpp(x, x, 0x141, 0xF, 0xF, false);
    else r = __builtin_amdgcn_update_dpp(x, x, 0x140, 0xF, 0xF, false);
    return __int_as_float(r);
}
__device__ __forceinline__ float wave_sum(float v) {
    v += dpp_f(v, 0); v += dpp_f(v, 1); v += dpp_f(v, 2); v += dpp_f(v, 3);
    const int x = __float_as_int(v);
    const float a = __int_as_float(__builtin_amdgcn_readlane(x, 0)), b = __int_as_float(__builtin_amdgcn_readlane(x, 16)), c = __int_as_float(__builtin_amdgcn_readlane(x, 32)), d = __int_as_float(__builtin_amdgcn_readlane(x, 48));
    return (a + b) + (c + d);
}

constexpr int NWAVES = 8;
constexpr int RING_BYTES = 131072, LDS_BYTES = 147456;

__device__ __forceinline__ unsigned pk4_fp8(float a, float b, float c, float d) { int v = __builtin_amdgcn_cvt_pk_fp8_f32(a, b, 0, false); v = __builtin_amdgcn_cvt_pk_fp8_f32(c, d, v, true); return (unsigned)v; }
__device__ __forceinline__ void p0_transpose_item_f8(const float* W, int K, int N, unsigned char* WT, int col0, float scale, LAS float* scr, int item, int lane) {
    const int nblk = N / 32, kb = item / nblk, nb = item % nblk, k0 = 64 * kb, n0 = 32 * nb;
#pragma unroll 8
    for (int i = 0; i < 32; ++i) { const int kk = 2 * i + (lane >> 5); scr[kk * 33 + (lane & 31)] = __builtin_nontemporal_load(&W[(size_t)(k0 + kk) * N + n0 + (lane & 31)]); }
    LDS_WAIT(); asm volatile("" ::: "memory");
    const int c = lane & 7;
#pragma unroll
    for (int j = 0; j < 4; ++j) { const int n = (lane >> 3) + 8 * j; const LAS float* q = scr + (8 * c) * 33 + n;
        v2u o; o.x = pk4_fp8(q[0 * 33] * scale, q[1 * 33] * scale, q[2 * 33] * scale, q[3 * 33] * scale); o.y = pk4_fp8(q[4 * 33] * scale, q[5 * 33] * scale, q[6 * 33] * scale, q[7 * 33] * scale);
        *(GAS v2u*)(WT + (size_t)(n0 + n - col0) * K + k0 + 8 * c) = o; }
    LDS_WAIT(); asm volatile("" ::: "memory");
}
template <bool NT = false>
__device__ __forceinline__ void p0_transpose_item(const float* W, int K, int N, bf16* WT, int row_off, LAS float* scr, int item, int lane) {
    const int nblk = N / 32, kb = item / nblk, nb = item % nblk, k0 = 64 * kb, n0 = 32 * nb;
#pragma unroll 8
    for (int i = 0; i < 32; ++i) { const int kk = 2 * i + (lane >> 5); scr[kk * 33 + (lane & 31)] = __builtin_nontemporal_load(&W[(size_t)(k0 + kk) * N + n0 + (lane & 31)]); }
    LDS_WAIT(); asm volatile("" ::: "memory");
    const int c = lane & 7;
#pragma unroll
    for (int j = 0; j < 4; ++j) { const int n = (lane >> 3) + 8 * j; const LAS float* s = scr + (8 * c) * 33 + n;
        v4u o; o.x = pk2(s[0 * 33], s[1 * 33]); o.y = pk2(s[2 * 33], s[3 * 33]); o.z = pk2(s[4 * 33], s[5 * 33]); o.w = pk2(s[6 * 33], s[7 * 33]);
        if (NT) __builtin_nontemporal_store(o, (v4u*)(WT + (size_t)(row_off + n0 + n) * K + k0 + 8 * c)); else *(GAS v4u*)(WT + (size_t)(row_off + n0 + n) * K + k0 + 8 * c) = o; }
    LDS_WAIT(); asm volatile("" ::: "memory");
}

__device__ __forceinline__ void rms_row_to_bf16(const float* xrow, const float* gain, bf16* orow, int lane) {
    const f32x4* xr = (const f32x4*)xrow + lane; const f32x4* gr = (const f32x4*)gain + lane;
    f32x4 v[8]; float s = 0.f;
#pragma unroll
    for (int j = 0; j < 8; ++j) { v[j] = xr[64 * j]; s += (v[j].x * v[j].x + v[j].y * v[j].y) + (v[j].z * v[j].z + v[j].w * v[j].w); }
    const float r = 1.0f / sqrtf(wave_sum(s) * (1.f / DM) + EPS);
    v2u* o8 = (v2u*)orow + lane;
#pragma unroll
    for (int j = 0; j < 8; ++j) { const f32x4 gg = gr[64 * j]; v2u w; w.x = pk2(v[j].x * r * gg.x, v[j].y * r * gg.y); w.y = pk2(v[j].z * r * gg.z, v[j].w * r * gg.w); o8[64 * j] = w; }
}

namespace att {
constexpr int KCH = 4112;
constexpr int PTP = 528;
constexpr int OSTE = 72;
constexpr int LDS_PT = 0, LDS_K = 0, LDS_V = 8 * KCH, LDS_WS = 128 * PTP, LDS_OST = LDS_WS + NWAVES * 256, LDS_TOTAL = LDS_OST + NWAVES * 32 * OSTE * 2;
static_assert(LDS_V + 32768 <= LDS_WS && LDS_TOTAL <= LDS_BYTES, "attention LDS");
__device__ __forceinline__ int crow(int r, int hi) { return (r & 3) + 8 * (r >> 2) + 4 * hi; }
typedef short v4i16_t __attribute__((ext_vector_type(4)));
__device__ __forceinline__ s16x4 vtr(const LAS unsigned char* p) { return __builtin_bit_cast(s16x4, __builtin_amdgcn_ds_read_tr16_b64_v4i16((LAS v4i16_t*)p)); }

template <int W, bool SAMPLE>
__device__ __forceinline__ void pool_tile(int b, int n, int h, const bf16* Zp, const float* hist, LAS unsigned char* lds, int tid) {
    constexpr int H = W - 1, R = 8;
    const int c8 = tid & 31, run = tid >> 5, c = h * 256 + c8 * 8;
    LAS unsigned char* dst = lds + LDS_PT + (8 * run) * PTP + c8 * 16;
    if (SAMPLE && run > 1) {
#pragma unroll
        for (int i = 0; i < R; ++i) *(LAS v4u*)(dst + i * PTP) = (v4u){0u, 0u, 0u, 0u};
        return;
    }
    const int t0 = SAMPLE ? 0 : n * 128 + 8 * run;
    const int bq = SAMPLE ? b + run : b;
    const int rg0 = SAMPLE ? NPR + bq * 8 : b * 2048 + t0;
    v4u rows[H + R];
    unsigned zo = (unsigned)zoff(0, UOFF + c) * 2u + (unsigned)(rg0 - H) * 128u;
#pragma unroll
    for (int q = 0; q < H; ++q) {
        if (SAMPLE) { const float* hp = hist + ((size_t)bq * 15 + (15 - H + q)) * DPOOL + c; const f32x4 h0 = *(const f32x4*)hp, h1 = *(const f32x4*)(hp + 4);
            rows[q] = (v4u){pk2(h0.x, h0.y), pk2(h0.z, h0.w), pk2(h1.x, h1.y), pk2(h1.z, h1.w)}; }
        else { rows[q] = (v4u){0u, 0u, 0u, 0u}; if (t0 - H + q >= 0) rows[q] = *(const v4u*)((const char*)Zp + zo); }
        zo += 128u; asm volatile("" : "+v"(zo));
    }
#pragma unroll
    for (int i = 0; i < R; ++i) { rows[H + i] = *(const v4u*)((const char*)Zp + zo); zo += 128u; asm volatile("" : "+v"(zo)); }
    float s[8];
#pragma unroll
    for (int e = 0; e < 8; ++e) s[e] = 0.f;
#pragma unroll
    for (int q = 0; q < H; ++q) { s[0] += bflo(rows[q].x); s[1] += bfhi(rows[q].x); s[2] += bflo(rows[q].y); s[3] += bfhi(rows[q].y); s[4] += bflo(rows[q].z); s[5] += bfhi(rows[q].z); s[6] += bflo(rows[q].w); s[7] += bfhi(rows[q].w); }
#pragma unroll
    for (int i = 0; i < R; ++i) {
        const v4u u = rows[H + i]; const float f[8] = {bflo(u.x), bfhi(u.x), bflo(u.y), bfhi(u.y), bflo(u.z), bfhi(u.z), bflo(u.w), bfhi(u.w)};
#pragma unroll
        for (int e = 0; e < 8; ++e) s[e] += f[e];
        const int cn = SAMPLE ? W : ((t0 + i + 1 < W) ? t0 + i + 1 : W); const float ic = 1.0f / (float)cn;
        v4u o; o.x = pk2(s[0] * ic - f[0], s[1] * ic - f[1]); o.y = pk2(s[2] * ic - f[2], s[3] * ic - f[3]); o.z = pk2(s[4] * ic - f[4], s[5] * ic - f[5]); o.w = pk2(s[6] * ic - f[6], s[7] * ic - f[7]);
        *(LAS v4u*)(dst + i * PTP) = o;
        const v4u d = rows[i];
        s[0] -= bflo(d.x); s[1] -= bfhi(d.x); s[2] -= bflo(d.y); s[3] -= bfhi(d.y); s[4] -= bflo(d.z); s[5] -= bfhi(d.z); s[6] -= bflo(d.w); s[7] -= bfhi(d.w);
    }
}

#define U8F(w, k) ((float)(((w) >> (8 * (k))) & 0xffu) * (1.0f / 255.0f))
template <bool SAMPLE>
__device__ __forceinline__ void mixer_unit(int b, int n, int h, const bf16* Z, const float* ck, const float* cv, const float* sinks, const float* hist, const bf16* Wp, const float* pscale, bf16* MX, LAS unsigned char* lds) {
    int tid = threadIdx.x; asm volatile("" : "+v"(tid));
    const int lane = tid & 63, r32 = lane & 31, hi = lane >> 5; const int wid = __builtin_amdgcn_readfirstlane(tid >> 6);
    const int g = wid;
    constexpr int NQT = SAMPLE ? 1 : 4;
    const size_t rowbase = SAMPLE ? (size_t)(NPR + b * 8) : (size_t)(b * 2048 + n * 128);
    LAS float* wsf = (LAS float*)(lds + LDS_WS) + wid * 64;
    LAS unsigned short* ost = (LAS unsigned short*)(lds + LDS_OST) + wid * (32 * OSTE);
    const unsigned char* G8 = (const unsigned char*)Z + G8_BYTE_OFF;
    const bf16* wb = Wp + (size_t)(h * 512 + g * 64 + r32) * 256 + hi * 8;
    bf16x8 bA[4][2], bB[4][2];
#define MX_LOADB(dst, k0) do { _Pragma("unroll") for (int kk = 0; kk < 4; ++kk) { dst[kk][0] = *(const bf16x8*)(wb + ((k0) + kk) * 16); dst[kk][1] = *(const bf16x8*)(wb + 32 * 256 + ((k0) + kk) * 16); } } while (0)
    MX_LOADB(bA, 0);
    if (h == 0) pool_tile<2, SAMPLE>(b, n, h, Z, hist, lds, tid); else if (h == 1) pool_tile<4, SAMPLE>(b, n, h, Z, hist, lds, tid);
    else if (h == 2) pool_tile<8, SAMPLE>(b, n, h, Z, hist, lds, tid); else pool_tile<16, SAMPLE>(b, n, h, Z, hist, lds, tid);
    __syncthreads();
    v4u kpre[4], vpre[4];
    {
        f32x16 acc[NQT][2];
#pragma unroll
        for (int qt = 0; qt < NQT; ++qt) { acc[qt][0] = f32x16{}; acc[qt][1] = f32x16{}; }
        const LAS unsigned char* ap = lds + LDS_PT + r32 * PTP + hi * 16;
#define MX_MMA(src, k0) do { _Pragma("unroll") for (int kk = 0; kk < 4; ++kk) { _Pragma("unroll") for (int qt = 0; qt < NQT; ++qt) { const bf16x8 a = *(const LAS bf16x8*)(ap + qt * 32 * PTP + ((k0) + kk) * 32); \
            acc[qt][0] = __builtin_amdgcn_mfma_f32_32x32x16_bf16(a, src[kk][0], acc[qt][0], 0, 0, 0); acc[qt][1] = __builtin_amdgcn_mfma_f32_32x32x16_bf16(a, src[kk][1], acc[qt][1], 0, 0, 0); } } } while (0)
        MX_LOADB(bB, 4); MX_MMA(bA, 0); MX_LOADB(bA, 8); MX_MMA(bB, 4); MX_LOADB(bB, 12); MX_MMA(bA, 8); MX_MMA(bB, 12);
#undef MX_MMA
#undef MX_LOADB
        if (!SAMPLE) {
#pragma unroll
            for (int i = 0; i < 4; ++i) { const int p = tid + 512 * i, row = p >> 3, c8 = p & 7; kpre[i] = (v4u){0u, 0u, 0u, 0u}; vpre[i] = (v4u){0u, 0u, 0u, 0u};
                if (n > 0 || row >= 128) { const size_t zr_ = (size_t)(b * 2048 + (n - 1) * 128 + row); kpre[i] = *(const v4u*)(Z + zoff(zr_, KOFF + h * 64 + c8 * 8)); vpre[i] = *(const v4u*)(Z + zoff(zr_, VOFF + h * 64 + c8 * 8)); } }
        }
        const float ps0 = pscale[h * 512 + g * 64 + r32], ps1 = pscale[h * 512 + g * 64 + 32 + r32];
        constexpr int NI4 = SAMPLE ? 2 : 4;
        v2u gpc[NI4], gpn[NI4];
#pragma unroll
        for (int i4 = 0; i4 < NI4; ++i4) gpc[i4] = *(const v2u*)(G8 + g8off(rowbase + i4 * 8 + (lane >> 3), 2048 + h * 512 + g * 64 + (lane & 7) * 8));
#pragma unroll
        for (int qt = 0; qt < NQT; ++qt) {
            if (qt + 1 < NQT) {
#pragma unroll
                for (int i4 = 0; i4 < NI4; ++i4) gpn[i4] = *(const v2u*)(G8 + g8off(rowbase + (qt + 1) * 32 + i4 * 8 + (lane >> 3), 2048 + h * 512 + g * 64 + (lane & 7) * 8)); }
#pragma unroll
            for (int r = 0; r < 16; ++r) { const int i = crow(r, hi); ost[i * OSTE + r32] = (unsigned short)f2bf(acc[qt][0][r] * ps0); ost[i * OSTE + 32 + r32] = (unsigned short)f2bf(acc[qt][1][r] * ps1); }
            LDS_WAIT();
#pragma unroll
            for (int i4 = 0; i4 < NI4; ++i4) { const int i = i4 * 8 + (lane >> 3), ch = lane & 7;
                const size_t row = rowbase + qt * 32 + i; const int col = h * 512 + g * 64 + ch * 8;
                const v4u pv = *(const LAS v4u*)(ost + i * OSTE + ch * 8);
                const v2u gp = gpc[i4];
                v4u w; w.x = pk2(bflo(pv.x) * U8F(gp.x, 0), bfhi(pv.x) * U8F(gp.x, 1)); w.y = pk2(bflo(pv.y) * U8F(gp.x, 2), bfhi(pv.y) * U8F(gp.x, 3));
                w.z = pk2(bflo(pv.z) * U8F(gp.y, 0), bfhi(pv.z) * U8F(gp.y, 1)); w.w = pk2(bflo(pv.w) * U8F(gp.y, 2), bfhi(pv.w) * U8F(gp.y, 3));
                *(v4u*)(MX + row * DM + col) = w; }
            LDS_WAIT();
#pragma unroll
            for (int i4 = 0; i4 < NI4; ++i4) gpc[i4] = gpn[i4];
        }
    }
    __syncthreads();
    for (int sq = 0; sq < (SAMPLE ? 2 : 1); ++sq) {
    const int bs = b + sq; const size_t rowatt = SAMPLE ? rowbase + 8 * sq : rowbase;
#pragma unroll
    for (int i = 0; i < 4; ++i) {
        const int p = tid + 512 * i, row = p >> 3, c8 = p & 7;
        v4u kv = (v4u){0u, 0u, 0u, 0u}, vv = (v4u){0u, 0u, 0u, 0u};
        if (!SAMPLE) { kv = kpre[i]; vv = vpre[i]; }
        else {
            if (row < 128) { const size_t off = ((size_t)(bs * 128 + row) * 4 + h) * 64 + c8 * 8;
                const f32x4 k0 = *(const f32x4*)(ck + off), k1 = *(const f32x4*)(ck + off + 4), v0 = *(const f32x4*)(cv + off), v1 = *(const f32x4*)(cv + off + 4);
                kv = (v4u){pk2(k0.x, k0.y), pk2(k0.z, k0.w), pk2(k1.x, k1.y), pk2(k1.z, k1.w)}; vv = (v4u){pk2(v0.x, v0.y), pk2(v0.z, v0.w), pk2(v1.x, v1.y), pk2(v1.z, v1.w)}; }
            else if (row < 136) { const size_t zr_ = (size_t)(NPR + bs * 8 + row - 128); kv = *(const v4u*)(Z + zoff(zr_, KOFF + h * 64 + c8 * 8)); vv = *(const v4u*)(Z + zoff(zr_, VOFF + h * 64 + c8 * 8)); }
        }
        *(LAS v4u*)(lds + LDS_K + c8 * KCH + row * 16) = kv;
        *(LAS v4u*)(lds + LDS_V + ((row >> 4) * 2 + (c8 >> 2)) * 1024 + (row & 15) * 64 + (c8 & 3) * 16) = vv;
    }
    __syncthreads();
    const float sink2 = sinks[h * 8 + g] * 1.4426950408889634f;
    const float SC = 0.125f * 1.4426950408889634f;
    const int vlane = ((lane >> 4) & 1) * 32 + (lane & 3) * 8 + (4 * hi + ((lane & 15) >> 2)) * 64;
    constexpr int NJ4 = SAMPLE ? 1 : 4;
    const bf16* qp0 = Z + zoff(SAMPLE ? (size_t)(NPR + bs * 8 + (r32 & 7)) : (size_t)(b * 2048 + n * 128 + r32), h * 512 + g * 64 + hi * 8);
    bf16x8 qr[4], qn[4];
#pragma unroll
    for (int d0 = 0; d0 < 4; ++d0) qr[d0] = *(const bf16x8*)(qp0 + d0 * 16);
    for (int qt = 0; qt < NQT; ++qt) {
        if (qt + 1 < NQT) {
#pragma unroll
            for (int d0 = 0; d0 < 4; ++d0) qn[d0] = *(const bf16x8*)(qp0 + (size_t)(qt + 1) * 32 * 64 + d0 * 16); }
        v2u gav[NJ4]; v4u pgv[NJ4];
#pragma unroll
        for (int i4 = 0; i4 < NJ4; ++i4) { const size_t row = rowatt + qt * 32 + i4 * 8 + (lane >> 3); const int col = h * 512 + g * 64 + (lane & 7) * 8;
            gav[i4] = *(const v2u*)(G8 + g8off(row, col)); pgv[i4] = *(const v4u*)(MX + row * DM + col); }
        f32x16 p[5];
#pragma unroll
        for (int kt = 0; kt < 5; ++kt) {
            f32x16 a = {};
#pragma unroll
            for (int d0 = 0; d0 < 4; ++d0) { const bf16x8 kf = *(const LAS bf16x8*)(lds + LDS_K + (2 * d0 + hi) * KCH + (32 * (qt + kt) + r32) * 16);
                a = __builtin_amdgcn_mfma_f32_32x32x16_bf16(kf, qr[d0], a, 0, 0, 0); }
            p[kt] = a;
        }
        float mx = -3.0e38f;
#pragma unroll
        for (int kt = 0; kt < 5; ++kt) {
            const bool dead = (!SAMPLE) && (n == 0) && (qt + kt < 4);
            if (dead) {
#pragma unroll
                for (int r = 0; r < 16; ++r) p[kt][r] = -1.0e30f;
            } else {
#pragma unroll
                for (int r = 0; r < 16; ++r) { const int jj = 32 * kt + crow(r, hi);
                    if (kt == 0) p[kt][r] = (jj > r32) ? p[kt][r] : -1.0e30f;
                    if (kt == 4) p[kt][r] = (jj <= r32 + 128) ? p[kt][r] : -1.0e30f;
                    mx = fmaxf(mx, p[kt][r]); }
            }
        }
        mx = fmaxf(mx, __shfl_xor(mx, 32));
        const float mfin = fmaxf(mx * SC, sink2);
        float ls = 0.f;
#pragma unroll
        for (int kt = 0; kt < 5; ++kt)
#pragma unroll
            for (int r = 0; r < 16; ++r) { const float e = __builtin_amdgcn_exp2f(__builtin_fmaf(p[kt][r], SC, -mfin)); p[kt][r] = e; ls += e; }
        ls += __shfl_xor(ls, 32);
        const float l = ls + __builtin_amdgcn_exp2f(sink2 - mfin);
        f32x16 o[2]; o[0] = f32x16{}; o[1] = f32x16{};
#pragma unroll
        for (int kt = 0; kt < 5; ++kt)
#pragma unroll
            for (int c = 0; c < 2; ++c) {
                v4u pw; pw.x = pk2(p[kt][8 * c + 0], p[kt][8 * c + 1]); pw.y = pk2(p[kt][8 * c + 2], p[kt][8 * c + 3]); pw.z = pk2(p[kt][8 * c + 4], p[kt][8 * c + 5]); pw.w = pk2(p[kt][8 * c + 6], p[kt][8 * c + 7]);
                const bf16x8 pa = __builtin_bit_cast(bf16x8, pw);
                const int kg = 2 * (qt + kt) + c;
#pragma unroll
                for (int d0 = 0; d0 < 2; ++d0) { const LAS unsigned char* vp = lds + LDS_V + (kg * 2 + d0) * 1024 + vlane;
                    const s16x4 lo = vtr(vp), hh = vtr(vp + 512);
                    const bf16x8 vf = (bf16x8){lo[0], lo[1], lo[2], lo[3], hh[0], hh[1], hh[2], hh[3]};
                    o[d0] = __builtin_amdgcn_mfma_f32_32x32x16_bf16(pa, vf, o[d0], 0, 0, 0); }
            }
        LDS_WAIT();
        if (hi == 0) wsf[r32] = l;
        LDS_WAIT();
#pragma unroll
        for (int r = 0; r < 16; ++r) { const int i = crow(r, hi); const float rl = __builtin_amdgcn_rcpf(wsf[i]);
            ost[i * OSTE + r32] = (unsigned short)f2bf(o[0][r] * rl); ost[i * OSTE + 32 + r32] = (unsigned short)f2bf(o[1][r] * rl); }
        LDS_WAIT();
#pragma unroll
        for (int i4 = 0; i4 < (SAMPLE ? 1 : 4); ++i4) { const int i = i4 * 8 + (lane >> 3), ch = lane & 7;
            const size_t row = rowatt + qt * 32 + i; const int col = h * 512 + g * 64 + ch * 8;
            const v4u av = *(const LAS v4u*)(ost + i * OSTE + ch * 8);
            const v2u ga = gav[i4];
            const v4u pg = pgv[i4];
            v4u w; w.x = pk2(bflo(pg.x) + bflo(av.x) * U8F(ga.x, 0), bfhi(pg.x) + bfhi(av.x) * U8F(ga.x, 1)); w.y = pk2(bflo(pg.y) + bflo(av.y) * U8F(ga.x, 2), bfhi(pg.y) + bfhi(av.y) * U8F(ga.x, 3));
            w.z = pk2(bflo(pg.z) + bflo(av.z) * U8F(ga.y, 0), bfhi(pg.z) + bfhi(av.z) * U8F(ga.y, 1)); w.w = pk2(bflo(pg.w) + bflo(av.w) * U8F(ga.y, 2), bfhi(pg.w) + bfhi(av.w) * U8F(ga.y, 3));
            *(v4u*)(MX + row * DM + col) = w; }
        LDS_WAIT();
#pragma unroll
        for (int d0 = 0; d0 < 4; ++d0) qr[d0] = qn[d0];
    }
    __syncthreads();
    }
}
}

__device__ __forceinline__ void grid_bar(unsigned* ctr, unsigned target) {
    asm volatile("s_waitcnt vmcnt(0) lgkmcnt(0)" ::: "memory");
    __syncthreads();
    if (threadIdx.x == 0) {
        __builtin_amdgcn_fence(__ATOMIC_RELEASE, "agent");
        asm volatile("s_waitcnt vmcnt(0)" ::: "memory");
        __hip_atomic_fetch_add(ctr, 1u, __ATOMIC_RELAXED, __HIP_MEMORY_SCOPE_AGENT);
        while (__hip_atomic_load(ctr, __ATOMIC_RELAXED, __HIP_MEMORY_SCOPE_AGENT) < target) __builtin_amdgcn_s_sleep(4);
        __builtin_amdgcn_fence(__ATOMIC_ACQUIRE, "agent");
        asm volatile("s_waitcnt vmcnt(0)" ::: "memory");
    }
    __syncthreads();
}

struct Args { const float* in[16]; float* out; unsigned char* ws; int ph_lo, ph_hi; };

__global__ void __launch_bounds__(NWAVES * 64, 2) mega_fwd(Args args) {
    extern __shared__ __attribute__((aligned(16))) unsigned char lds_raw[];
    LAS unsigned char* lds = (LAS unsigned char*)lds_raw;
    const int tid = threadIdx.x, lane = tid & 63, wave = __builtin_amdgcn_readfirstlane(tid >> 6);
    const int G = gridDim.x, bx = blockIdx.x;
    const int vcu = (G % 8 == 0) ? (bx % 8) * (G / 8) + bx / 8 : bx;
    const int gw = vcu * NWAVES + wave, NGW = G * NWAVES;
    const size_t gt = (size_t)bx * (NWAVES * 64) + tid, NGT = (size_t)G * (NWAVES * 64);
#define x_p (args.in[0])
#define x_s (args.in[1])
#define cache_k (args.in[2])
#define cache_v (args.in[3])
#define state_pool (args.in[4])
#define g_attn_pre (args.in[5])
#define g_attn_post (args.in[6])
#define w_in (args.in[7])
#define sinks (args.in[8])
#define w_pool (args.in[9])
#define pool_scale (args.in[10])
#define w_out (args.in[11])
#define g_mlp_pre (args.in[12])
#define g_mlp_post (args.in[13])
#define w_up (args.in[14])
#define w_down (args.in[15])
#define out (args.out)
#define Win_t ((bf16*)(args.ws + WS_WIN))
#define Wout_t ((bf16*)(args.ws + WS_WOUT))
#define Wup_t ((bf16*)(args.ws + WS_WUP))
#define Wdn_t ((bf16*)(args.ws + WS_WDN))
#define Wpool_t ((bf16*)(args.ws + WS_WPOOL))
#define XN ((bf16*)(args.ws + WS_XN))
#define Z ((bf16*)(args.ws + WS_R))
#define XN8 ((unsigned char*)(args.ws + WS_POOLED))
#define W8_t ((unsigned char*)(args.ws + WS_W8))
#define SPB ((float*)(args.ws + WS_SP))
#define MX XN
#define OB Z
#define HM Z
#define FB XN
    const int lo = args.ph_lo, hi = args.ph_hi;
    if (blockIdx.x == 0 && threadIdx.x < 16 && lo == 0 && hi > 1)
        __hip_atomic_store((unsigned*)args.ws + 64 * threadIdx.x, 0u, __ATOMIC_RELAXED, __HIP_MEMORY_SCOPE_AGENT);
#ifdef ONLY_PHASE
#define IN(k) ((k) == ONLY_PHASE && lo <= (k) && (k) < hi)
#else
#define IN(k) (lo <= (k) && (k) < hi)
#endif
#define SEAM(k) do { if ((k) != 3 && IN(k) && IN((k) + 1)) { if ((k) == 0) cg::this_grid().sync(); else { grid_bar((unsigned*)args.ws + 64 * (k), (unsigned)G); if (PROBE_DBLBAR) grid_bar((unsigned*)args.ws + 64 * ((k) + 16), (unsigned)G); } } } while (0)

    for (int rep_ = 0; rep_ < ((PROBE_REPEAT_MASK >> 0) & 1) + 1; ++rep_)
    if (IN(0)) {
        LAS float* scr = (LAS float*)(lds + wave * 16384);
        constexpr int I_IN = (DM / 64) * (DIN / 32), I_OUT = (DM / 64) * (DM / 32), I_UP = (DM / 64) * (DFF / 32), I_DN = (DFF / 64) * (DM / 32), I_PG = (256 / 64) * (512 / 32);
        constexpr int NITEMS = I_IN + I_OUT + I_UP + I_DN + 4 * I_PG;
        for (int it = gw; it < NITEMS; it += NGW) {
            int r = it;
            if (r < I_IN) { if (r % (DIN / 32) < NBF / 32) p0_transpose_item(w_in, DM, DIN, Win_t, 0, scr, r, lane); else p0_transpose_item_f8(w_in, DM, DIN, W8_t, NBF, 32.0f, scr, r, lane); continue; } r -= I_IN;
            if (r < I_OUT) { p0_transpose_item<true>(w_out, DM, DM, Wout_t, 0, scr, r, lane); continue; } r -= I_OUT;
            if (r < I_UP) { p0_transpose_item<true>(w_up, DM, DFF, Wup_t, 0, scr, r, lane); continue; } r -= I_UP;
            if (r < I_DN) { p0_transpose_item<true>(w_down, DFF, DM, Wdn_t, 0, scr, r, lane); continue; } r -= I_DN;
            const int gi = r / I_PG; p0_transpose_item(w_pool + (size_t)gi * 256 * 512, 256, 512, Wpool_t, gi * 512, scr, r % I_PG, lane);
        }
        {
            __syncthreads();
            LAS f32x4* gl1 = (LAS f32x4*)lds; gl1[tid] = ((const f32x4*)g_attn_pre)[tid];
            __syncthreads();
#define P0_XROW(m_) ((const f32x4*)((m_) < NPR ? x_p + (size_t)(m_) * DM : x_s + (size_t)((m_) - NPR) * DM) + lane)
            f32x4 xa[8];
            if (gw < MROWS) { const f32x4* xr_ = P0_XROW(gw);
#pragma unroll
                for (int j = 0; j < 8; ++j) xa[j] = __builtin_nontemporal_load(xr_ + 64 * j); }
            for (int m = gw; m < MROWS; m += NGW) {
                f32x4 xb[8]; const int mn = m + NGW;
                if (mn < MROWS) { const f32x4* xr_ = P0_XROW(mn);
#pragma unroll
                    for (int j = 0; j < 8; ++j) xb[j] = __builtin_nontemporal_load(xr_ + 64 * j); }
                float s_ = 0.f;
#pragma unroll
                for (int j = 0; j < 8; ++j) s_ += (xa[j].x * xa[j].x + xa[j].y * xa[j].y) + (xa[j].z * xa[j].z + xa[j].w * xa[j].w);
                const float r_ = 1.0f / sqrtf(wave_sum(s_) * (1.f / DM) + EPS); v2u* o8_ = (v2u*)(XN + (size_t)m * DM) + lane; int lq_ = lane; asm volatile("" : "+v"(lq_));
#pragma unroll
                for (int j = 0; j < 8; ++j) { const f32x4 gg = gl1[lq_ + 64 * j]; const f32x4 hv = xa[j] * r_ * gg; v2u w; w.x = pk2(hv.x, hv.y); w.y = pk2(hv.z, hv.w); o8_[64 * j] = w;
                    ((unsigned*)(XN8 + (size_t)m * DM))[lq_ + 64 * j] = pk4_fp8(hv.x, hv.y, hv.z, hv.w); }
#pragma unroll
                for (int j = 0; j < 8; ++j) xa[j] = xb[j];
            }
#undef P0_XROW
            __syncthreads();
        }
    }
    SEAM(0);
    for (int rep_ = 0; rep_ < ((PROBE_REPEAT_MASK >> 1) & 1) + 1; ++rep_)
    if (IN(1)) {
        constexpr int NU8 = (MROWS / 256) * (NF8 / 256), NUB = (MROWS / 256) * (NBF / 256);
        {   pg8::Gemm g{(const pg8::bf16_t*)XN8, (const pg8::bf16_t*)W8_t, MROWS, NF8, DM / 2, DM / 2, DM / 2, 0, 0};
            pg8::StaticOrder S; S.init(MROWS, NF8, G, bx);
            pg8::EpiGate8 E{(unsigned char*)Z + G8_BYTE_OFF, 1.0f / 32.0f};
            pg8::gemm_phase<pg8::EpiGate8, false, -1, true>(lds, g, S, E); }
        {   pg8::Gemm g{XN, Win_t, MROWS, NBF, DM, DM, DM, 0, 0}; pg8::StaticOrder S; S.init(MROWS, NBF, G, bx);
            S.base = ((NU8 - bx + G - 1) / G) * G - NU8; S.limit = NUB;
            pg8::EpiBf16<0> E{Z, DIN, nullptr, 0, 1.0f, 0};
            pg8::gemm_phase<pg8::EpiBf16<0>>(lds, g, S, E); }
    }
    SEAM(1);
    for (int rep_ = 0; rep_ < ((PROBE_REPEAT_MASK >> 2) & 1) + 1; ++rep_)
    if (IN(2)) {
        {
            constexpr size_t N_KP = 65536, N_PP = 30720, N_KS = 1048576, N_PS = 491520;
            constexpr size_t T0 = N_KP, T1 = T0 + N_KP, T2 = T1 + N_PP, T3 = T2 + N_KS, T4 = T3 + N_KS, T5 = T4 + N_PS;
            for (int rB_ = 0; rB_ < PROBE_P2B; ++rB_)
            for (size_t it0 = gt; it0 < T5; it0 += 8 * NGT) {
                f32x4 vv[8]; float* dd[8];
#pragma unroll
                for (int k4 = 0; k4 < 8; ++k4) { const size_t it = it0 + (size_t)k4 * NGT; f32x4 v = (f32x4){0.f, 0.f, 0.f, 0.f}; float* dst = nullptr; if (it < T5) {
                if (it < T1) { const bool isv = it >= T0; const size_t e = (isv ? it - T0 : it) * 4; const int c = (int)(e & 255), j = (int)((e >> 8) & 127), b = (int)(e >> 15);
                    const v2u z = *(const v2u*)(Z + zoff((size_t)(b * 2048 + 1920 + j), (isv ? VOFF : KOFF) + c)); v = (f32x4){bflo(z.x), bfhi(z.x), bflo(z.y), bfhi(z.y)}; dst = out + (isv ? O_VP : O_KP) + e; }
                else if (it < T2) { const size_t e = (it - T1) * 4; const int c = (int)(e & 1023), r = (int)((e >> 10) % 15), b = (int)((e >> 10) / 15);
                    const v2u z = *(const v2u*)(Z + zoff((size_t)(b * 2048 + 2033 + r), UOFF + c)); v = (f32x4){bflo(z.x), bfhi(z.x), bflo(z.y), bfhi(z.y)}; dst = out + O_PP + e; }
                else if (it < T4) { const bool isv = it >= T3; const size_t e = (isv ? it - T3 : it - T2) * 4; const int c = (int)(e & 255), j = (int)((e >> 8) & 127), b = (int)(e >> 15);
                    if (j < 120) v = *(const f32x4*)((isv ? cache_v : cache_k) + ((size_t)b * 128 + j + 8) * 256 + c);
                    else { const v2u z = *(const v2u*)(Z + zoff((size_t)(NPR + b * 8 + j - 120), (isv ? VOFF : KOFF) + c)); v = (f32x4){bflo(z.x), bfhi(z.x), bflo(z.y), bfhi(z.y)}; }
                    dst = out + (isv ? O_VS : O_KS) + e; }
                else { const size_t e = (it - T4) * 4; const int c = (int)(e & 1023), r = (int)((e >> 10) % 15), b = (int)((e >> 10) / 15);
                    if (r < 7) v = *(const f32x4*)(state_pool + ((size_t)b * 15 + r + 8) * DPOOL + c);
                    else { const v2u z = *(const v2u*)(Z + zoff((size_t)(NPR + b * 8 + r - 7), UOFF + c)); v = (f32x4){bflo(z.x), bfhi(z.x), bflo(z.y), bfhi(z.y)}; }
                    dst = out + O_PS + e; }
                } vv[k4] = v; dd[k4] = dst; }
#pragma unroll
                for (int k4 = 0; k4 < 8; ++k4) if (dd[k4]) __builtin_nontemporal_store(vv[k4], (f32x4*)dd[k4]);
            }
        }
        for (int rC_ = 0; rC_ < PROBE_P2C; ++rC_)
        for (int u = vcu; u < 512; u += G) att::mixer_unit<false>(u >> 6, (u >> 2) & 15, u & 3, Z, cache_k, cache_v, sinks, state_pool, Wpool_t, pool_scale, MX, lds);
        for (int rD_ = 0; rD_ < PROBE_P2D; ++rD_)
        for (int u = vcu; u < 256; u += G) att::mixer_unit<true>(2 * (u >> 2), 0, u & 3, Z, cache_k, cache_v, sinks, state_pool, Wpool_t, pool_scale, MX, lds);
    }
    SEAM(2);
    if (IN(3)) {   }
    SEAM(3);
    for (int rep_ = 0; rep_ < ((PROBE_REPEAT_MASK >> 4) & 1) + 1; ++rep_)
    if (IN(4)) {
        pg8::Gemm g{MX, Wout_t, MROWS, DM, DM, DM, DM, 0, 0}; pg8::StaticOrder S; S.init(MROWS, DM, G, bx, TAILP, KSPLIT);
        pg8::EpiBf16<0> E{OB, DM, SPB, NPR};
        pg8::gemm_phase<pg8::EpiBf16<0>>(lds, g, S, E);
    }
    SEAM(4);
    for (int rep_ = 0; rep_ < ((PROBE_REPEAT_MASK >> 5) & 1) + 1; ++rep_)
    if (IN(5)) {
        LAS f32x4* gl1 = (LAS f32x4*)lds; LAS f32x4* gl2 = (LAS f32x4*)(lds + 8192);
        gl1[tid] = ((const f32x4*)g_attn_post)[tid]; gl2[tid] = ((const f32x4*)g_mlp_pre)[tid];
        __syncthreads();
#define P5_LOAD(m_, XV, OV) do { const f32x4* xr_ = (const f32x4*)(x_p + (size_t)(m_) * DM) + lane; const v2u* or_ = (const v2u*)(OB + (size_t)(m_) * DM) + lane; \
            _Pragma("unroll") for (int j = 0; j < 8; ++j) { XV[j] = __builtin_nontemporal_load(xr_ + 64 * j); OV[j] = __builtin_nontemporal_load(or_ + 64 * j); } } while (0)
#define P5_BODY(m_, XV, V) do { float s_ = 0.f; int lq_ = lane; asm volatile("" : "+v"(lq_));        \
            _Pragma("unroll") for (int j = 0; j < 8; ++j) s_ += (V[j].x * V[j].x + V[j].y * V[j].y) + (V[j].z * V[j].z + V[j].w * V[j].w); \
            const float r1_ = 1.0f / sqrtf(wave_sum(s_) * (1.f / DM) + EPS); float s2_ = 0.f; v2u* yr_ = (v2u*)(out + (size_t)(m_) * DM + DM / 2) + lane;        \
            _Pragma("unroll") for (int j = 0; j < 8; ++j) { const f32x4 gg = gl1[lq_ + 64 * j]; V[j] = XV[j] + V[j] * r1_ * gg; v2u w1_; w1_.x = pk2(V[j].x, V[j].y); w1_.y = pk2(V[j].z, V[j].w); __builtin_nontemporal_store(w1_, yr_ + 64 * j); s2_ += (V[j].x * V[j].x + V[j].y * V[j].y) + (V[j].z * V[j].z + V[j].w * V[j].w); } \
            const float r2_ = 1.0f / sqrtf(wave_sum(s2_) * (1.f / DM) + EPS); v2u* o8_ = (v2u*)(XN + (size_t)(m_) * DM) + lane; \
            _Pragma("unroll") for (int j = 0; j < 8; ++j) { const f32x4 gg = gl2[lq_ + 64 * j]; v2u w; w.x = pk2(V[j].x * r2_ * gg.x, V[j].y * r2_ * gg.y); w.y = pk2(V[j].z * r2_ * gg.z, V[j].w * r2_ * gg.w); o8_[64 * j] = w; } } while (0)
        {
            f32x4 xa[8]; v2u oa[8];
            if (gw < NPR) P5_LOAD(gw, xa, oa);
            for (int m = gw; m < NPR; m += NGW) {
                f32x4 xb[8]; v2u ob[8]; const int mn = m + NGW;
                if (mn < NPR) P5_LOAD(mn, xb, ob);
                f32x4 v[8];
#pragma unroll
                for (int j = 0; j < 8; ++j) v[j] = (f32x4){bflo(oa[j].x), bfhi(oa[j].x), bflo(oa[j].y), bfhi(oa[j].y)};
                P5_BODY(m, xa, v);
#pragma unroll
                for (int j = 0; j < 8; ++j) { xa[j] = xb[j]; oa[j] = ob[j]; }
            }
        }
        if ((gw & 1) == 0)
        for (int m = NPR + (gw >> 1); m < MROWS; m += (NGW >> 1)) {
            const f32x4* xr_ = (const f32x4*)(x_s + (size_t)(m - NPR) * DM) + lane; f32x4 xv[8], v[8];
#pragma unroll
            for (int j = 0; j < 8; ++j) { xv[j] = xr_[64 * j]; v[j] = (f32x4){0.f, 0.f, 0.f, 0.f}; }
            { const char* spb_ = (const char*)SPB; unsigned so_ = (unsigned)(m - NPR) * (DM * 2u) + (unsigned)lane * 8u;
#pragma unroll 2
              for (int q = 0; q < KSPLIT; ++q) {
#pragma unroll
                for (int j = 0; j < 8; ++j) { const v2u w_ = *(const v2u*)(spb_ + (so_ + (unsigned)j * 512u)); v[j] = v[j] + (f32x4){bflo(w_.x), bfhi(w_.x), bflo(w_.y), bfhi(w_.y)}; }
                so_ += 1024u * DM * 2u; } }
            P5_BODY(m, xv, v);
        }
#undef P5_LOAD
#undef P5_BODY
        __syncthreads();
    }
    SEAM(5);
    for (int rep_ = 0; rep_ < ((PROBE_REPEAT_MASK >> 6) & 1) + 1; ++rep_)
    if (IN(6)) {
        pg8::Gemm g{XN, Wup_t, MROWS, DFF, DM, DM, DM, 0, 0}; pg8::StaticOrder S; S.init(MROWS, DFF, G, bx, 0, 1, ((MROWS / 256) * (DFF / 256) / G) * G);
        pg8::EpiBf16<2> E{HM, DFF, nullptr, 0};
        S.limit = S.hs0; pg8::gemm_phase<pg8::EpiBf16<2>>(lds, g, S, E);
        S.base = S.hs0; S.limit = S.nwg;
        if (((S.base + bx) & 1) == 0) pg8::gemm_phase<pg8::EpiBf16<2>, true, 0>(lds, g, S, E); else pg8::gemm_phase<pg8::EpiBf16<2>, true, 1>(lds, g, S, E);
    }
    SEAM(6);
    for (int rep_ = 0; rep_ < ((PROBE_REPEAT_MASK >> 7) & 1) + 1; ++rep_)
    if (IN(7)) {
        pg8::Gemm g{HM, Wdn_t, MROWS, DM, DFF, DFF, DFF, 0, 0}; pg8::StaticOrder S; S.init(MROWS, DM, G, bx, TAILP, KSPLIT);
        pg8::EpiBf16<0> E{FB, DM, SPB, NPR};
        pg8::gemm_phase<pg8::EpiBf16<0>>(lds, g, S, E);
    }
    SEAM(7);
    if (IN(8)) {
        LAS f32x4* gl1 = (LAS f32x4*)lds;
        gl1[tid] = ((const f32x4*)g_mlp_post)[tid];
        __syncthreads();
#define P8_LOAD(m_, YV, FV) do { const v2u* yr_ = (const v2u*)(out + (size_t)(m_) * DM + DM / 2) + lane; const v2u* fr_ = (const v2u*)(FB + (size_t)(m_) * DM) + lane; \
            _Pragma("unroll") for (int j = 0; j < 8; ++j) { YV[j] = __builtin_nontemporal_load(yr_ + 64 * j); FV[j] = __builtin_nontemporal_load(fr_ + 64 * j); } } while (0)
#define P8_BODY(m_, YV, V) do { float s_ = 0.f; int lq_ = lane; asm volatile("" : "+v"(lq_)); \
            _Pragma("unroll") for (int j = 0; j < 8; ++j) s_ += (V[j].x * V[j].x + V[j].y * V[j].y) + (V[j].z * V[j].z + V[j].w * V[j].w); \
            const float r1_ = 1.0f / sqrtf(wave_sum(s_) * (1.f / DM) + EPS); f32x4* yw_ = (f32x4*)(out + (size_t)(m_) * DM) + lane; \
            _Pragma("unroll") for (int j = 0; j < 8; ++j) { const f32x4 gg = gl1[lq_ + 64 * j]; const f32x4 x1_ = (f32x4){bflo(YV[j].x), bfhi(YV[j].x), bflo(YV[j].y), bfhi(YV[j].y)}; __builtin_nontemporal_store(x1_ + V[j] * r1_ * gg, yw_ + 64 * j); } } while (0)
        {
            v2u ya[8]; v2u fa[8];
            if (gw < NPR) P8_LOAD(gw, ya, fa);
            for (int m = gw; m < NPR; m += NGW) {
                v2u yb[8]; v2u fb[8]; const int mn = m + NGW;
                if (mn < NPR) P8_LOAD(mn, yb, fb);
                f32x4 v[8];
#pragma unroll
                for (int j = 0; j < 8; ++j) v[j] = (f32x4){bflo(fa[j].x), bfhi(fa[j].x), bflo(fa[j].y), bfhi(fa[j].y)};
                P8_BODY(m, ya, v);
#pragma unroll
                for (int j = 0; j < 8; ++j) { ya[j] = yb[j]; fa[j] = fb[j]; }
            }
        }
        if ((gw & 1) == 0)
        for (int m = NPR + (gw >> 1); m < MROWS; m += (NGW >> 1)) {
            const v2u* yr_ = (const v2u*)(out + (size_t)m * DM + DM / 2) + lane; v2u yv[8]; f32x4 v[8];
#pragma unroll
            for (int j = 0; j < 8; ++j) { yv[j] = yr_[64 * j]; v[j] = (f32x4){0.f, 0.f, 0.f, 0.f}; }
            { const char* spb_ = (const char*)SPB; unsigned so_ = (unsigned)(m - NPR) * (DM * 2u) + (unsigned)lane * 8u;
#pragma unroll 2
              for (int q = 0; q < KSPLIT; ++q) {
#pragma unroll
                for (int j = 0; j < 8; ++j) { const v2u w_ = *(const v2u*)(spb_ + (so_ + (unsigned)j * 512u)); v[j] = v[j] + (f32x4){bflo(w_.x), bfhi(w_.x), bflo(w_.y), bfhi(w_.y)}; }
                so_ += 1024u * DM * 2u; } }
            P8_BODY(m, yv, v);
        }
#undef P8_LOAD
#undef P8_BODY
    }
#undef IN
#undef SEAM
#undef x_p
#undef x_s
#undef cache_k
#undef cache_v
#undef state_pool
#undef g_attn_pre
#undef g_attn_post
#undef w_in
#undef sinks
#undef w_pool
#undef pool_scale
#undef w_out
#undef g_mlp_pre
#undef g_mlp_post
#undef w_up
#undef w_down
#undef out
#undef Z
#undef XN
#undef MX
#undef OB
#undef HM
#undef FB
}

extern "C" void kernel_launch(void* const* d_in, const int* in_sizes, int n_in, void* d_out, int out_size, void* d_ws, size_t ws_size, hipStream_t stream) {
    static int grid = 0;
    if (grid == 0) {
        if (n_in != 16 || (size_t)out_size != O_END || ws_size < WS_END) { fprintf(stderr, "kernel_launch: unexpected shapes (n_in %d out %d ws %zu)\n", n_in, out_size, ws_size); grid = -1; return; }
        int dev = 0, cus = 0, per_cu = 0;
        if (hipGetDevice(&dev) != hipSuccess || hipDeviceGetAttribute(&cus, hipDeviceAttributeMultiprocessorCount, dev) != hipSuccess) { grid = -1; return; }
        if (hipFuncSetAttribute((const void*)mega_fwd, hipFuncAttributeMaxDynamicSharedMemorySize, LDS_BYTES) != hipSuccess) { fprintf(stderr, "kernel_launch: hipFuncSetAttribute failed\n"); grid = -1; return; }
        if (hipOccupancyMaxActiveBlocksPerMultiprocessor(&per_cu, (const void*)mega_fwd, NWAVES * 64, LDS_BYTES) != hipSuccess || per_cu < 1) { fprintf(stderr, "kernel_launch: occupancy query says %d\n", per_cu); per_cu = 1; }
        (void)hipGetLastError();
        grid = cus;
    }
    if (grid < 0) return;
    Args a{};
    for (int i = 0; i < 16; ++i) a.in[i] = (const float*)d_in[i];
    a.out = (float*)d_out; a.ws = (unsigned char*)d_ws;
#if MK_N_LAUNCHES == 1
    a.ph_lo = 0; a.ph_hi = N_PHASES;
    void* kargs[] = {(void*)&a};
    hipError_t e = hipLaunchCooperativeKernel((const void*)mega_fwd, dim3(grid), dim3(NWAVES * 64), kargs, LDS_BYTES, stream);
    if (e != hipSuccess) fprintf(stderr, "kernel_launch: cooperative launch failed: %s (grid %d)\n", hipGetErrorString(e), grid);
#ifdef PROBE_EXTRA_PHASE
    a.ph_lo = PROBE_EXTRA_PHASE; a.ph_hi = PROBE_EXTRA_PHASE + 1;
    hipLaunchKernelGGL(mega_fwd, dim3(grid), dim3(NWAVES * 64), LDS_BYTES, stream, a);
#endif
#else
    for (int li = 0; li < N_PHASES; ++li) { a.ph_lo = li; a.ph_hi = li + 1; hipLaunchKernelGGL(mega_fwd, dim3(grid), dim3(NWAVES * 64), LDS_BYTES, stream, a); }
#endif
}
```

```cpp
#include <hip/hip_runtime.h>
#include <hip/hip_cooperative_groups.h>
#include <cstdio>
#include <cstdint>
namespace cg = cooperative_groups;

#ifndef MK_N_LAUNCHES
#define MK_N_LAUNCHES 1
#endif
constexpr int N_PHASES = 9;
#ifndef PROBE_P2A
#define PROBE_P2A 1
#endif
#ifndef PROBE_P2C
#define PROBE_P2C 1
#endif
#ifndef PROBE_P2D
#define PROBE_P2D 1
#endif
#ifndef PROBE_DBLBAR
#define PROBE_DBLBAR 0
#endif
#ifndef PROBE_P2B
#define PROBE_P2B 1
#endif
#ifndef PROBE_REPEAT_MASK
#define PROBE_REPEAT_MASK 0
#endif

constexpr int DM = 2048, NPR = 16384, NSR = 1024, MROWS = NPR + NSR;
constexpr int DIN = 7680, DFF = 8192, DPOOL = 1024;
constexpr int KOFF = 2048, VOFF = 2304, UOFF = 2560, GAOFF = 3584, GPOFF = 5632;
constexpr float EPS = 1e-6f;
constexpr size_t G8_BYTE_OFF = (size_t)56 * 17408 * 128;
__host__ __device__ __forceinline__ size_t g8off(size_t row, int gcol) { return ((size_t)(gcol >> 6) * 17408 + row) * 64 + (size_t)(gcol & 63); }
__host__ __device__ __forceinline__ size_t zoff(size_t row, int col) { return ((size_t)(col >> 6) * 17408 + row) * 64 + (size_t)(col & 63); }
constexpr size_t O_YP = 0, O_KP = 35651584, O_VP = 35913728, O_PP = 36175872, O_KS = 36298752, O_VS = 40493056, O_PS = 44687360, O_END = 46653440;
constexpr size_t MiB = 1u << 20;
constexpr size_t WS_WIN = 1 * MiB, WS_WOUT = 31 * MiB, WS_WUP = 39 * MiB, WS_WDN = 71 * MiB, WS_WPOOL = 103 * MiB;
constexpr size_t WS_XN = 104 * MiB;
constexpr size_t WS_R = 172 * MiB;
constexpr size_t WS_POOLED = 427 * MiB;
constexpr size_t WS_W8 = 17 * MiB;
constexpr int NBF = 3584, NF8 = 4096;
constexpr size_t WS_SP = 444 * MiB, WS_END = 508 * MiB;
constexpr int KSPLIT = 8, TAILP = 4;

#define GAS __attribute__((address_space(1)))
#define LAS __attribute__((address_space(3)))

namespace pg8 {
typedef unsigned short bf16_t;
typedef short bf16x8 __attribute__((ext_vector_type(8)));
typedef float f32x4 __attribute__((ext_vector_type(4)));
typedef unsigned u32x4 __attribute__((ext_vector_type(4)));
typedef int i32x4 __attribute__((ext_vector_type(4)));
constexpr int BM = 256, BK = 64, HALF = 128, HTB = HALF * BK * 2, STAGE_BYTES = 8 * HTB, NXCD = 8, WGM = 8;

__host__ __device__ __forceinline__ int lds_byte(int r, int c) { const int st = (r >> 4) * 2 + (c >> 5), rr = r & 15, cc = c & 31, ob = rr * 64 + cc * 2; return st * 1024 + (ob ^ (((ob >> 9) & 1) << 5)); }
__host__ __device__ __forceinline__ void stage_rc(int b, int& R, int& C) { const int st = b / 1024, sb = b % 1024, swz = sb ^ (((sb >> 9) & 1) << 5); R = (st >> 1) * 16 + swz / 64; C = (st & 1) * 32 + (swz % 64) / 2; }
__host__ __device__ __forceinline__ int perm32(int rho) { const int n = rho >> 4, i = rho & 15; return 8 * (i >> 2) + 4 * n + (i & 3); }

struct Unit { int pm, pn, ks, hb; };
struct Gemm { const bf16_t* A; const bf16_t* Bt; int M, N, K, lda, ldb, ag_shift, ag_bytes; };

struct StaticOrder {
    int nM, nN, nwg, G, c, nMf, nfull, ksplit, hs0, base, limit;
    __host__ __device__ void init(int M, int N, int G_, int c_, int tail = 0, int ksplit_ = 1, int hs0_ = -1) { nM = M / BM; nN = N / BM; nMf = nM - tail; nfull = nMf * nN; ksplit = ksplit_;
        hs0 = hs0_ < 0 ? nfull : hs0_; nwg = hs0 + 2 * (nfull - hs0) + tail * nN * ksplit_; G = G_; c = c_; base = 0; limit = nwg; }
    __host__ __device__ bool next(int i, Unit& u) const {
        const long L = base + (long)i * G + c; if (L >= limit) return false;
        const int nfl = hs0 + 2 * (nfull - hs0);
        const bool tl = L >= nfl;
        const int Lp = (int)L - nfl, idx = Lp / ksplit;
        const bool hf = !tl && L >= hs0;
        int wgid = tl ? 0 : (hf ? hs0 + (((int)L - hs0) >> 1) : (int)L);
        { const int q = nfull / NXCD, r = nfull % NXCD, xcd = wgid % NXCD, off = wgid / NXCD; wgid = (xcd < r ? xcd * (q + 1) : r * (q + 1) + (xcd - r) * q) + off; }
        const int nig = WGM * nN, gid = wgid / nig, fm = gid * WGM, gsz = (nMf - fm) < WGM ? (nMf - fm) : WGM;
        const int pm = tl ? nMf + idx / nN : fm + ((wgid % nig) % gsz), pn = tl ? idx % nN : (wgid % nig) / gsz, ks = tl ? Lp % ksplit : -1, hb = hf ? (((int)L - hs0) & 1) : -1;
        u.pm = pm; u.pn = pn; u.ks = ks; u.hb = hb; return true;
    }
};

__device__ __forceinline__ unsigned cvt_pk_bf16(float lo, float hi) { unsigned r; asm volatile("v_cvt_pk_bf16_f32 %0, %1, %2" : "=v"(r) : "v"(lo), "v"(hi)); return r; }
__device__ __forceinline__ float bf_lo(unsigned w) { return __uint_as_float(w << 16); }
__device__ __forceinline__ float bf_hi(unsigned w) { return __uint_as_float(w & 0xffff0000u); }
__device__ __forceinline__ float sigmoidf_(float x) { return __builtin_amdgcn_rcpf(1.0f + __builtin_amdgcn_exp2f(-1.4426950408889634f * x)); }

template <int ACT  > struct EpiBf16 {
    static constexpr bool PERM = true;
    bf16_t* O; int ldc; float* SP; int sp_row0;
    float sc = 1.0f;
    int cg0 = -1;
    __device__ __forceinline__ void partial(const f32x4 (&acc)[2][2][4][2], const Unit& u, int wr, int wc, int fr, int fq) const {
        const int row0 = u.pm * BM + wr * 64 + fr - sp_row0 + u.ks * 1024; const int col0 = u.pn * BM + wc * 32 + 8 * fq;
#pragma unroll
        for (int ai = 0; ai < 2; ++ai)
#pragma unroll
            for (int m = 0; m < 4; ++m) { bf16_t* rowp = (bf16_t*)SP + (size_t)(row0 + ai * HALF + m * 16) * ldc + col0;
#pragma unroll
                for (int bj = 0; bj < 2; ++bj) { const f32x4 v0 = acc[ai][bj][m][0], v1 = acc[ai][bj][m][1];
                    typedef float f2_ __attribute__((ext_vector_type(2))); typedef __bf16 b2_ __attribute__((ext_vector_type(2)));
                    u32x4 w; w.x = __builtin_bit_cast(unsigned, __builtin_convertvector((f2_){v0[0], v0[1]}, b2_)); w.y = __builtin_bit_cast(unsigned, __builtin_convertvector((f2_){v0[2], v0[3]}, b2_));
                    w.z = __builtin_bit_cast(unsigned, __builtin_convertvector((f2_){v1[0], v1[1]}, b2_)); w.w = __builtin_bit_cast(unsigned, __builtin_convertvector((f2_){v1[2], v1[3]}, b2_));
                    *(u32x4*)(rowp + bj * HALF) = w; asm volatile("; split-K partial tile" ::: "memory"); } }
    }
    __device__ __forceinline__ void operator()(const f32x4 (&acc)[2][2][4][2], const Unit& u, int wr, int wc, int fr, int fq) const {
        const int row0 = u.pm * BM + wr * 64 + fr; const int col0 = u.pn * BM + wc * 32 + 8 * fq;
#pragma unroll
        for (int ai = 0; ai < 2; ++ai)
#pragma unroll
            for (int m = 0; m < 4; ++m) { bf16_t* rowp = O + (size_t)(row0 + ai * HALF + m * 16) * ldc + col0;
#pragma unroll
                for (int bj = 0; bj < 2; ++bj) { if (u.hb >= 0 && u.hb != bj) continue;
                    if (cg0 >= 0) rowp = O + zoff((size_t)(row0 + ai * HALF + m * 16), cg0 + col0 + bj * HALF) - bj * HALF; f32x4 v0 = acc[ai][bj][m][0], v1 = acc[ai][bj][m][1];
                    if (ACT == 2) {
#pragma unroll
                        for (int e = 0; e < 4; ++e) { const float a = fmaxf(v0[e], 0.f), b = fmaxf(v1[e], 0.f); v0[e] = a * a; v1[e] = b * b; } }
                    v0 = v0 * sc; v1 = v1 * sc;
                    u32x4 w; w.x = cvt_pk_bf16(v0[0], v0[1]); w.y = cvt_pk_bf16(v0[2], v0[3]); w.z = cvt_pk_bf16(v1[0], v1[1]); w.w = cvt_pk_bf16(v1[2], v1[3]);
                    *(u32x4*)(rowp + bj * HALF) = w; } }
    }
};
struct EpiGate8 {
    static constexpr bool PERM = true;
    unsigned char* G; float sc;
    __device__ __forceinline__ void partial(const f32x4 (&)[2][2][4][2], const Unit&, int, int, int, int) const {}
    __device__ __forceinline__ void operator()(const f32x4 (&acc)[2][2][4][2], const Unit& u, int wr, int wc, int fr, int fq) const {
        const int row0 = u.pm * BM + wr * 64 + fr; const int col0 = u.pn * BM + wc * 32 + 8 * fq;
#pragma unroll
        for (int ai = 0; ai < 2; ++ai)
#pragma unroll
            for (int m = 0; m < 4; ++m)
#pragma unroll
                for (int bj = 0; bj < 2; ++bj) { const f32x4 v0 = acc[ai][bj][m][0] * sc, v1 = acc[ai][bj][m][1] * sc;
                    unsigned q[8];
#pragma unroll
                    for (int e = 0; e < 4; ++e) { q[e] = (unsigned)(sigmoidf_(v0[e]) * 255.0f + 0.5f); q[4 + e] = (unsigned)(sigmoidf_(v1[e]) * 255.0f + 0.5f); }
                    typedef unsigned u32x2 __attribute__((ext_vector_type(2)));
                    u32x2 w; w.x = q[0] | (q[1] << 8) | (q[2] << 16) | (q[3] << 24); w.y = q[4] | (q[5] << 8) | (q[6] << 16) | (q[7] << 24);
                    *(u32x2*)(G + g8off((size_t)(row0 + ai * HALF + m * 16), col0 + bj * HALF)) = w; }
    }
};
struct EpiPool {
    static constexpr bool PERM = true;
    bf16_t* MX; const bf16_t* Z; const float* ps;
    __device__ __forceinline__ void partial(const f32x4 (&)[2][2][4][2], const Unit&, int, int, int, int) const {}
    __device__ __forceinline__ void operator()(const f32x4 (&acc)[2][2][4][2], const Unit& u, int wr, int wc, int fr, int fq) const {
        const int row0 = u.pm * BM + wr * 64 + fr; const int col0 = u.pn * BM + wc * 32 + 8 * fq;
        f32x4 sc[2][2];
#pragma unroll
        for (int bj = 0; bj < 2; ++bj) { sc[bj][0] = *(const f32x4*)(ps + col0 + bj * HALF); sc[bj][1] = *(const f32x4*)(ps + col0 + bj * HALF + 4); }
        unsigned om = (unsigned)(row0 * DM + col0) * 2u, oz = (unsigned)(row0 * DIN + GPOFF + col0) * 2u;
#pragma unroll
        for (int ai = 0; ai < 2; ++ai) {
#pragma unroll
            for (int m = 0; m < 4; ++m) {
#pragma unroll
                for (int bj = 0; bj < 2; ++bj) {
                    char* mp = (char*)MX + om + bj * (HALF * 2); const u32x4 ag = *(const u32x4*)mp; const u32x4 gp = *(const u32x4*)((const char*)Z + oz + bj * (HALF * 2));
                    const f32x4 v0 = acc[ai][bj][m][0] * sc[bj][0], v1 = acc[ai][bj][m][1] * sc[bj][1];
                    u32x4 w;
                    w.x = cvt_pk_bf16(bf_lo(ag.x) + sigmoidf_(bf_lo(gp.x)) * v0[0], bf_hi(ag.x) + sigmoidf_(bf_hi(gp.x)) * v0[1]);
                    w.y = cvt_pk_bf16(bf_lo(ag.y) + sigmoidf_(bf_lo(gp.y)) * v0[2], bf_hi(ag.y) + sigmoidf_(bf_hi(gp.y)) * v0[3]);
                    w.z = cvt_pk_bf16(bf_lo(ag.z) + sigmoidf_(bf_lo(gp.z)) * v1[0], bf_hi(ag.z) + sigmoidf_(bf_hi(gp.z)) * v1[1]);
                    w.w = cvt_pk_bf16(bf_lo(ag.w) + sigmoidf_(bf_lo(gp.w)) * v1[2], bf_hi(ag.w) + sigmoidf_(bf_hi(gp.w)) * v1[3]);
                    *(u32x4*)mp = w; }
                om += 16u * DM * 2u; oz += 16u * DIN * 2u; asm volatile("" : "+v"(om), "+v"(oz) :: "memory"); }
            om += 64u * DM * 2u; oz += 64u * DIN * 2u; }
    }
};

template <class Epi, bool ALIGN_EPI = true, int HB = -1, bool FP8 = false>
__device__ __forceinline__ void gemm_phase(LAS unsigned char* lds, const Gemm g, const StaticOrder& S, const Epi& E) {
    int tid = threadIdx.x; asm volatile("" : "+v"(tid));
    const int wid = __builtin_amdgcn_readfirstlane(tid >> 6), lane = tid & 63, wr = wid >> 2, wc = wid & 3, fr = lane & 15, fq = lane >> 4;
    int nt_full = g.K / BK; asm volatile("" : "+s"(nt_full));
    const int nt_split = nt_full / S.ksplit;
    unsigned voffA[2], voffB[2];
#pragma unroll
    for (int i = 0; i < 2; ++i) { int R, C; stage_rc(tid * 16 + i * 8192, R, C); const int Rb = Epi::PERM ? ((R & ~31) + perm32(R & 31)) : R;
        voffA[i] = (unsigned)(R * g.lda + C) * 2u; voffB[i] = (unsigned)(Rb * g.ldb + C) * 2u; }
    const size_t kstep = (size_t)(BK * 2);
    const size_t hstepA = (size_t)HALF * g.lda * 2, hstepB = (size_t)HALF * g.ldb * 2;
    const size_t tstepA = 2 * hstepA, tstepB = 2 * hstepB;
    const unsigned ldsw = (unsigned)wid * 1024u;
    const int aoff = lds_byte(wr * 64 + fr, fq * 8), boff = lds_byte(wc * 32 + fr, fq * 8);
#define PG8_SA(b, h) (((b) * 2 + (h)) * HTB)
#define PG8_SB(b, h) ((4 + (b) * 2 + (h)) * HTB)
#define PG8_STAGE(bufoff, gbase, voff) do { _Pragma("unroll") for (int _i = 0; _i < 2; ++_i) \
        __builtin_amdgcn_global_load_lds((const unsigned*)((const char*)(gbase) + (voff)[_i]), (LAS unsigned*)(lds + (bufoff) + ldsw + _i * 8192), 16, 0, 0); } while (0)
#define PG8_LDA(dst, b, h) do { _Pragma("unroll") for (int m = 0; m < 4; ++m) _Pragma("unroll") for (int k = 0; k < 2; ++k) dst[m][k] = *(const LAS bf16x8*)(lds + PG8_SA(b, h) + aoff + m * 2048 + k * 1024); } while (0)
#define PG8_LDB(dst, b, h) do { _Pragma("unroll") for (int n = 0; n < 2; ++n) _Pragma("unroll") for (int k = 0; k < 2; ++k) dst[n][k] = *(const LAS bf16x8*)(lds + PG8_SB(b, h) + boff + n * 2048 + k * 1024); } while (0)
#define PG8_CAT(x0, x1) __builtin_shufflevector(__builtin_bit_cast(i32x4, x0), __builtin_bit_cast(i32x4, x1), 0, 1, 2, 3, 4, 5, 6, 7)
#define PG8_MMA(ai, bj, At, Bt) do { __builtin_amdgcn_s_setprio(1); _Pragma("unroll") for (int m = 0; m < 4; ++m) _Pragma("unroll") for (int n = 0; n < 2; ++n) { \
        if constexpr (FP8) { asm volatile("v_mfma_scale_f32_16x16x128_f8f6f4 %0, %1, %2, %0, %3, %3 op_sel_hi:[0,0,0]" : "+v"(acc[ai][bj][m][n]) : "v"(PG8_CAT(Bt[n][0], Bt[n][1])), "v"(PG8_CAT(At[m][0], At[m][1])), "v"(sc127)); } \
        else { _Pragma("unroll") for (int k = 0; k < 2; ++k) acc[ai][bj][m][n] = __builtin_amdgcn_mfma_f32_16x16x32_bf16(Bt[n][k], At[m][k], acc[ai][bj][m][n], 0, 0, 0); } } \
        __builtin_amdgcn_s_setprio(0); } while (0)
#define PG8_WAIT_V(n) asm volatile("s_waitcnt vmcnt(" #n ")" ::: "memory")
#define PG8_WAIT_L(n) asm volatile("s_waitcnt lgkmcnt(" #n ")" ::: "memory")
#define PG8_BAR __builtin_amdgcn_s_barrier()
#define PG8_SCHED __builtin_amdgcn_sched_barrier(0)
#define PG8_KO(u) ((u).ks < 0 ? (size_t)0 : (size_t)((u).ks * nt_split) * kstep)
#define PG8_UA(u) ((const char*)g.A + (size_t)(u).pm * tstepA + (size_t)((u).pn >> g.ag_shift) * (size_t)g.ag_bytes + PG8_KO(u))
#define PG8_UB(u) ((const char*)g.Bt + (size_t)(u).pn * tstepB + PG8_KO(u))
    Unit cur, nxt; int ui = 0;
    if (!S.next(0, cur)) return;
    const int sc127 = 127;
    f32x4 acc[2][2][4][2];
#pragma unroll
    for (int a = 0; a < 2; ++a)
#pragma unroll
        for (int b = 0; b < 2; ++b)
#pragma unroll
            for (int m = 0; m < 4; ++m)
#pragma unroll
                for (int n = 0; n < 2; ++n) acc[a][b][m][n] = (f32x4){0.f, 0.f, 0.f, 0.f};
    bf16x8 At[4][2], B0[2][2], B1[2][2];
    const char* cA = PG8_UA(cur); const char* cB = PG8_UB(cur); int nt = cur.ks < 0 ? nt_full : nt_split;
    PG8_STAGE(PG8_SB(0, 0), cB, voffB); PG8_STAGE(PG8_SB(0, 1), cB + hstepB, voffB); PG8_STAGE(PG8_SA(0, 0), cA, voffA); PG8_STAGE(PG8_SA(0, 1), cA + hstepA, voffA);
    if (wr == 1) PG8_BAR;
    PG8_WAIT_V(2); PG8_BAR;
    PG8_STAGE(PG8_SB(1, 0), cB + kstep, voffB); PG8_STAGE(PG8_SA(1, 0), cA + kstep, voffA); PG8_STAGE(PG8_SB(1, 1), cB + hstepB + kstep, voffB);
    PG8_WAIT_V(6); PG8_BAR;
    for (;;) {
        const bool has_next = S.next(ui + 1, nxt);
        const char* nA = has_next ? PG8_UA(nxt) : cA; const char* nB = has_next ? PG8_UB(nxt) : cB;
        for (int t = 0; t < nt; t += 2) {
            const bool last = (t == nt - 2);
            const char* a1 = cA + (size_t)(t + 1) * kstep;
            const char* a2 = last ? nA : cA + (size_t)(t + 2) * kstep; const char* b2 = last ? nB : cB + (size_t)(t + 2) * kstep;
            const char* a3 = a2 + kstep; const char* b3 = b2 + kstep;
            PG8_LDB(B0, 0, 0); PG8_LDB(B1, 0, 1); PG8_SCHED; PG8_LDA(At, 0, 0); PG8_STAGE(PG8_SA(1, 1), a1 + hstepA, voffA);
            PG8_WAIT_V(8); PG8_WAIT_L(0); PG8_BAR; if constexpr (HB != 1) PG8_MMA(0, 0, At, B0); if constexpr (HB != 0) PG8_MMA(0, 1, At, B1); PG8_BAR; PG8_SCHED;
            PG8_LDA(At, 0, 1); PG8_STAGE(PG8_SB(0, 0), b2, voffB); PG8_STAGE(PG8_SB(0, 1), b2 + hstepB, voffB); PG8_STAGE(PG8_SA(0, 0), a2, voffA);
            PG8_WAIT_V(8); PG8_WAIT_L(0); PG8_BAR; if constexpr (HB != 1) PG8_MMA(1, 0, At, B0); if constexpr (HB != 0) PG8_MMA(1, 1, At, B1); PG8_BAR; PG8_SCHED;
            PG8_LDB(B0, 1, 0); PG8_LDB(B1, 1, 1); PG8_SCHED; PG8_LDA(At, 1, 0); PG8_STAGE(PG8_SA(0, 1), a2 + hstepA, voffA);
            PG8_WAIT_V(8); PG8_WAIT_L(0); PG8_BAR; if constexpr (HB != 1) PG8_MMA(0, 0, At, B0); if constexpr (HB != 0) PG8_MMA(0, 1, At, B1); PG8_BAR; PG8_SCHED;
            PG8_LDA(At, 1, 1); PG8_STAGE(PG8_SB(1, 0), b3, voffB); PG8_STAGE(PG8_SB(1, 1), b3 + hstepB, voffB); PG8_STAGE(PG8_SA(1, 0), a3, voffA);
            PG8_WAIT_V(8); PG8_WAIT_L(0); PG8_BAR; if constexpr (HB != 1) PG8_MMA(1, 0, At, B0); if constexpr (HB != 0) PG8_MMA(1, 1, At, B1); PG8_BAR; PG8_SCHED;
        }
        if constexpr (ALIGN_EPI) { if (wr == 0) PG8_BAR; }
        if constexpr (FP8) asm volatile("s_nop 15\n\ts_nop 15" ::: "memory");
        if (cur.ks < 0) E(acc, cur, wr, wc, fr, fq); else E.partial(acc, cur, wr, wc, fr, fq);
        if (!has_next) break;
#pragma unroll
        for (int a = 0; a < 2; ++a)
#pragma unroll
            for (int b = 0; b < 2; ++b)
#pragma unroll
                for (int m = 0; m < 4; ++m)
#pragma unroll
                    for (int n = 0; n < 2; ++n) acc[a][b][m][n] = (f32x4){0.f, 0.f, 0.f, 0.f};
        cur = nxt; cA = nA; cB = nB; ++ui; nt = cur.ks < 0 ? nt_full : nt_split;
        if constexpr (ALIGN_EPI) { if (wr == 1) PG8_BAR; }
    }
    PG8_WAIT_V(0);
    if constexpr (!ALIGN_EPI) { if (wr == 0) PG8_BAR; }
    PG8_BAR;
#undef PG8_SA
#undef PG8_SB
#undef PG8_STAGE
#undef PG8_LDA
#undef PG8_LDB
#undef PG8_MMA
#undef PG8_CAT
#undef PG8_WAIT_V
#undef PG8_WAIT_L
#undef PG8_BAR
#undef PG8_SCHED
#undef PG8_UA
#undef PG8_KO
#undef PG8_UB
}
}

typedef unsigned short bf16;
typedef unsigned v4u __attribute__((ext_vector_type(4)));
typedef unsigned v2u __attribute__((ext_vector_type(2)));
typedef float f32x4 __attribute__((ext_vector_type(4)));
typedef float f32x16 __attribute__((ext_vector_type(16)));
typedef short bf16x8 __attribute__((ext_vector_type(8)));
typedef short s16x4 __attribute__((ext_vector_type(4)));
#define LDS_WAIT() asm volatile("s_waitcnt lgkmcnt(0)" ::: "memory")
__device__ __forceinline__ unsigned f2bf(float f) { unsigned u = __builtin_bit_cast(unsigned, f); return (u + 0x7fffu + ((u >> 16) & 1u)) >> 16; }
typedef float f32x2_t __attribute__((ext_vector_type(2))); typedef __bf16 bf16x2_t __attribute__((ext_vector_type(2)));
__device__ __forceinline__ unsigned pk2(float lo, float hi) { f32x2_t v = {lo, hi}; bf16x2_t b = __builtin_convertvector(v, bf16x2_t); return __builtin_bit_cast(unsigned, b); }
__device__ __forceinline__ float bflo(unsigned w) { return __uint_as_float(w << 16); }
__device__ __forceinline__ float bfhi(unsigned w) { return __uint_as_float(w & 0xffff0000u); }
__device__ __forceinline__ float dpp_f(float v, const int ctrl_sel) {
    const int x = __float_as_int(v);
    int r;
    if (ctrl_sel == 0) r = __builtin_amdgcn_update_dpp(x, x, 0xB1, 0xF, 0xF, false);
    else if (ctrl_sel == 1) r = __builtin_amdgcn_update_dpp(x, x, 0x4E, 0xF, 0xF, false);
    else if (ctrl_sel == 2) r = __builtin_amdgcn_update_dpp(x, x, 0x141, 0xF, 0xF, false);
    else r = __builtin_amdgcn_update_dpp(x, x, 0x140, 0xF, 0xF, false);
    return __int_as_float(r);
}
__device__ __forceinline__ float wave_sum(float v) {
    v += dpp_f(v, 0); v += dpp_f(v, 1); v += dpp_f(v, 2); v += dpp_f(v, 3);
    const int x = __float_as_int(v);
    const float a = __int_as_float(__builtin_amdgcn_readlane(x, 0)), b = __int_as_float(__builtin_amdgcn_readlane(x, 16)), c = __int_as_float(__builtin_amdgcn_readlane(x, 32)), d = __int_as_float(__builtin_amdgcn_readlane(x, 48));
    return (a + b) + (c + d);
}

constexpr int NWAVES = 8;
constexpr int RING_BYTES = 131072, LDS_BYTES = 147456;

__device__ __forceinline__ unsigned pk4_fp8(float a, float b, float c, float d) { int v = __builtin_amdgcn_cvt_pk_fp8_f32(a, b, 0, false); v = __builtin_amdgcn_cvt_pk_fp8_f32(c, d, v, true); return (unsigned)v; }
__device__ __forceinline__ void p0_transpose_item_f8(const float* W, int K, int N, unsigned char* WT, int col0, float scale, LAS float* scr, int item, int lane) {
    const int nblk = N / 32, kb = item / nblk, nb = item % nblk, k0 = 64 * kb, n0 = 32 * nb;
#pragma unroll 8
    for (int i = 0; i < 32; ++i) { const int kk = 2 * i + (lane >> 5); scr[kk * 33 + (lane & 31)] = __builtin_nontemporal_load(&W[(size_t)(k0 + kk) * N + n0 + (lane & 31)]); }
    LDS_WAIT(); asm volatile("" ::: "memory");
    const int c = lane & 7;
#pragma unroll
    for (int j = 0; j < 4; ++j) { const int n = (lane >> 3) + 8 * j; const LAS float* q = scr + (8 * c) * 33 + n;
        v2u o; o.x = pk4_fp8(q[0 * 33] * scale, q[1 * 33] * scale, q[2 * 33] * scale, q[3 * 33] * scale); o.y = pk4_fp8(q[4 * 33] * scale, q[5 * 33] * scale, q[6 * 33] * scale, q[7 * 33] * scale);
        *(GAS v2u*)(WT + (size_t)(n0 + n - col0) * K + k0 + 8 * c) = o; }
    LDS_WAIT(); asm volatile("" ::: "memory");
}
template <bool NT = false>
__device__ __forceinline__ void p0_transpose_item(const float* W, int K, int N, bf16* WT, int row_off, LAS float* scr, int item, int lane) {
    const int nblk = N / 32, kb = item / nblk, nb = item % nblk, k0 = 64 * kb, n0 = 32 * nb;
#pragma unroll 8
    for (int i = 0; i < 32; ++i) { const int kk = 2 * i + (lane >> 5); scr[kk * 33 + (lane & 31)] = __builtin_nontemporal_load(&W[(size_t)(k0 + kk) * N + n0 + (lane & 31)]); }
    LDS_WAIT(); asm volatile("" ::: "memory");
    const int c = lane & 7;
#pragma unroll
    for (int j = 0; j < 4; ++j) { const int n = (lane >> 3) + 8 * j; const LAS float* s = scr + (8 * c) * 33 + n;
        v4u o; o.x = pk2(s[0 * 33], s[1 * 33]); o.y = pk2(s[2 * 33], s[3 * 33]); o.z = pk2(s[4 * 33], s[5 * 33]); o.w = pk2(s[6 * 33], s[7 * 33]);
        if (NT) __builtin_nontemporal_store(o, (v4u*)(WT + (size_t)(row_off + n0 + n) * K + k0 + 8 * c)); else *(GAS v4u*)(WT + (size_t)(row_off + n0 + n) * K + k0 + 8 * c) = o; }
    LDS_WAIT(); asm volatile("" ::: "memory");
}

__device__ __forceinline__ void rms_row_to_bf16(const float* xrow, const float* gain, bf16* orow, int lane) {
    const f32x4* xr = (const f32x4*)xrow + lane; const f32x4* gr = (const f32x4*)gain + lane;
    f32x4 v[8]; float s = 0.f;
#pragma unroll
    for (int j = 0; j < 8; ++j) { v[j] = xr[64 * j]; s += (v[j].x * v[j].x + v[j].y * v[j].y) + (v[j].z * v[j].z + v[j].w * v[j].w); }
    const float r = 1.0f / sqrtf(wave_sum(s) * (1.f / DM) + EPS);
    v2u* o8 = (v2u*)orow + lane;
#pragma unroll
    for (int j = 0; j < 8; ++j) { const f32x4 gg = gr[64 * j]; v2u w; w.x = pk2(v[j].x * r * gg.x, v[j].y * r * gg.y); w.y = pk2(v[j].z * r * gg.z, v[j].w * r * gg.w); o8[64 * j] = w; }
}

namespace att {
constexpr int KCH = 4112;
constexpr int PTP = 528;
constexpr int OSTE = 72;
constexpr int LDS_PT = 0, LDS_K = 0, LDS_V = 8 * KCH, LDS_WS = 128 * PTP, LDS_OST = LDS_WS + NWAVES * 256, LDS_TOTAL = LDS_OST + NWAVES * 32 * OSTE * 2;
static_assert(LDS_V + 32768 <= LDS_WS && LDS_TOTAL <= LDS_BYTES, "attention LDS");
__device__ __forceinline__ int crow(int r, int hi) { return (r & 3) + 8 * (r >> 2) + 4 * hi; }
typedef short v4i16_t __attribute__((ext_vector_type(4)));
__device__ __forceinline__ s16x4 vtr(const LAS unsigned char* p) { return __builtin_bit_cast(s16x4, __builtin_amdgcn_ds_read_tr16_b64_v4i16((LAS v4i16_t*)p)); }

template <int W, bool SAMPLE>
__device__ __forceinline__ void pool_tile(int b, int n, int h, const bf16* Zp, const float* hist, LAS unsigned char* lds, int tid) {
    constexpr int H = W - 1, R = 8;
    const int c8 = tid & 31, run = tid >> 5, c = h * 256 + c8 * 8;
    LAS unsigned char* dst = lds + LDS_PT + (8 * run) * PTP + c8 * 16;
    if (SAMPLE && run > 1) {
#pragma unroll
        for (int i = 0; i < R; ++i) *(LAS v4u*)(dst + i * PTP) = (v4u){0u, 0u, 0u, 0u};
        return;
    }
    const int t0 = SAMPLE ? 0 : n * 128 + 8 * run;
    const int bq = SAMPLE ? b + run : b;
    const int rg0 = SAMPLE ? NPR + bq * 8 : b * 2048 + t0;
    v4u rows[H + R];
    unsigned zo = (unsigned)zoff(0, UOFF + c) * 2u + (unsigned)(rg0 - H) * 128u;
#pragma unroll
    for (int q = 0; q < H; ++q) {
        if (SAMPLE) { const float* hp = hist + ((size_t)bq * 15 + (15 - H + q)) * DPOOL + c; const f32x4 h0 = *(const f32x4*)hp, h1 = *(const f32x4*)(hp + 4);
            rows[q] = (v4u){pk2(h0.x, h0.y), pk2(h0.z, h0.w), pk2(h1.x, h1.y), pk2(h1.z, h1.w)}; }
        else { rows[q] = (v4u){0u, 0u, 0u, 0u}; if (t0 - H + q >= 0) rows[q] = *(const v4u*)((const char*)Zp + zo); }
        zo += 128u; asm volatile("" : "+v"(zo));
    }
#pragma unroll
    for (int i = 0; i < R; ++i) { rows[H + i] = *(const v4u*)((const char*)Zp + zo); zo += 128u; asm volatile("" : "+v"(zo)); }
    float s[8];
#pragma unroll
    for (int e = 0; e < 8; ++e) s[e] = 0.f;
#pragma unroll
    for (int q = 0; q < H; ++q) { s[0] += bflo(rows[q].x); s[1] += bfhi(rows[q].x); s[2] += bflo(rows[q].y); s[3] += bfhi(rows[q].y); s[4] += bflo(rows[q].z); s[5] += bfhi(rows[q].z); s[6] += bflo(rows[q].w); s[7] += bfhi(rows[q].w); }
#pragma unroll
    for (int i = 0; i < R; ++i) {
        const v4u u = rows[H + i]; const float f[8] = {bflo(u.x), bfhi(u.x), bflo(u.y), bfhi(u.y), bflo(u.z), bfhi(u.z), bflo(u.w), bfhi(u.w)};
#pragma unroll
        for (int e = 0; e < 8; ++e) s[e] += f[e];
        const int cn = SAMPLE ? W : ((t0 + i + 1 < W) ? t0 + i + 1 : W); const float ic = 1.0f / (float)cn;
        v4u o; o.x = pk2(s[0] * ic - f[0], s[1] * ic - f[1]); o.y = pk2(s[2] * ic - f[2], s[3] * ic - f[3]); o.z = pk2(s[4] * ic - f[4], s[5] * ic - f[5]); o.w = pk2(s[6] * ic - f[6], s[7] * ic - f[7]);
        *(LAS v4u*)(dst + i * PTP) = o;
        const v4u d = rows[i];
        s[0] -= bflo(d.x); s[1] -= bfhi(d.x); s[2] -= bflo(d.y); s[3] -= bfhi(d.y); s[4] -= bflo(d.z); s[5] -= bfhi(d.z); s[6] -= bflo(d.w); s[7] -= bfhi(d.w);
    }
}

#define U8F(w, k) ((float)(((w) >> (8 * (k))) & 0xffu) * (1.0f / 255.0f))
template <bool SAMPLE>
__device__ __forceinline__ void mixer_unit(int b, int n, int h, const bf16* Z, const float* ck, const float* cv, const float* sinks, const float* hist, const bf16* Wp, const float* pscale, bf16* MX, LAS unsigned char* lds) {
    int tid = threadIdx.x; asm volatile("" : "+v"(tid));
    const int lane = tid & 63, r32 = lane & 31, hi = lane >> 5; const int wid = __builtin_amdgcn_readfirstlane(tid >> 6);
    const int g = wid;
    constexpr int NQT = SAMPLE ? 1 : 4;
    const size_t rowbase = SAMPLE ? (size_t)(NPR + b * 8) : (size_t)(b * 2048 + n * 128);
    LAS float* wsf = (LAS float*)(lds + LDS_WS) + wid * 64;
    LAS unsigned short* ost = (LAS unsigned short*)(lds + LDS_OST) + wid * (32 * OSTE);
    const unsigned char* G8 = (const unsigned char*)Z + G8_BYTE_OFF;
    const bf16* wb = Wp + (size_t)(h * 512 + g * 64 + r32) * 256 + hi * 8;
    bf16x8 bA[4][2], bB[4][2];
#define MX_LOADB(dst, k0) do { _Pragma("unroll") for (int kk = 0; kk < 4; ++kk) { dst[kk][0] = *(const bf16x8*)(wb + ((k0) + kk) * 16); dst[kk][1] = *(const bf16x8*)(wb + 32 * 256 + ((k0) + kk) * 16); } } while (0)
    MX_LOADB(bA, 0);
    if (h == 0) pool_tile<2, SAMPLE>(b, n, h, Z, hist, lds, tid); else if (h == 1) pool_tile<4, SAMPLE>(b, n, h, Z, hist, lds, tid);
    else if (h == 2) pool_tile<8, SAMPLE>(b, n, h, Z, hist, lds, tid); else pool_tile<16, SAMPLE>(b, n, h, Z, hist, lds, tid);
    __syncthreads();
    v4u kpre[4], vpre[4];
    {
        f32x16 acc[NQT][2];
#pragma unroll
        for (int qt = 0; qt < NQT; ++qt) { acc[qt][0] = f32x16{}; acc[qt][1] = f32x16{}; }
        const LAS unsigned char* ap = lds + LDS_PT + r32 * PTP + hi * 16;
#define MX_MMA(src, k0) do { _Pragma("unroll") for (int kk = 0; kk < 4; ++kk) { _Pragma("unroll") for (int qt = 0; qt < NQT; ++qt) { const bf16x8 a = *(const LAS bf16x8*)(ap + qt * 32 * PTP + ((k0) + kk) * 32); \
            acc[qt][0] = __builtin_amdgcn_mfma_f32_32x32x16_bf16(a, src[kk][0], acc[qt][0], 0, 0, 0); acc[qt][1] = __builtin_amdgcn_mfma_f32_32x32x16_bf16(a, src[kk][1], acc[qt][1], 0, 0, 0); } } } while (0)
        MX_LOADB(bB, 4); MX_MMA(bA, 0); MX_LOADB(bA, 8); MX_MMA(bB, 4); MX_LOADB(bB, 12); MX_MMA(bA, 8); MX_MMA(bB, 12);
#undef MX_MMA
#undef MX_LOADB
        if (!SAMPLE) {
#pragma unroll
            for (int i = 0; i < 4; ++i) { const int p = tid + 512 * i, row = p >> 3, c8 = p & 7; kpre[i] = (v4u){0u, 0u, 0u, 0u}; vpre[i] = (v4u){0u, 0u, 0u, 0u};
                if (n > 0 || row >= 128) { const size_t zr_ = (size_t)(b * 2048 + (n - 1) * 128 + row); kpre[i] = *(const v4u*)(Z + zoff(zr_, KOFF + h * 64 + c8 * 8)); vpre[i] = *(const v4u*)(Z + zoff(zr_, VOFF + h * 64 + c8 * 8)); } }
        }
        const float ps0 = pscale[h * 512 + g * 64 + r32], ps1 = pscale[h * 512 + g * 64 + 32 + r32];
        constexpr int NI4 = SAMPLE ? 2 : 4;
        v2u gpc[NI4], gpn[NI4];
#pragma unroll
        for (int i4 = 0; i4 < NI4; ++i4) gpc[i4] = *(const v2u*)(G8 + g8off(rowbase + i4 * 8 + (lane >> 3), 2048 + h * 512 + g * 64 + (lane & 7) * 8));
#pragma unroll
        for (int qt = 0; qt < NQT; ++qt) {
            if (qt + 1 < NQT) {
#pragma unroll
                for (int i4 = 0; i4 < NI4; ++i4) gpn[i4] = *(const v2u*)(G8 + g8off(rowbase + (qt + 1) * 32 + i4 * 8 + (lane >> 3), 2048 + h * 512 + g * 64 + (lane & 7) * 8)); }
#pragma unroll
            for (int r = 0; r < 16; ++r) { const int i = crow(r, hi); ost[i * OSTE + r32] = (unsigned short)f2bf(acc[qt][0][r] * ps0); ost[i * OSTE + 32 + r32] = (unsigned short)f2bf(acc[qt][1][r] * ps1); }
            LDS_WAIT();
#pragma unroll
            for (int i4 = 0; i4 < NI4; ++i4) { const int i = i4 * 8 + (lane >> 3), ch = lane & 7;
                const size_t row = rowbase + qt * 32 + i; const int col = h * 512 + g * 64 + ch * 8;
                const v4u pv = *(const LAS v4u*)(ost + i * OSTE + ch * 8);
                const v2u gp = gpc[i4];
                v4u w; w.x = pk2(bflo(pv.x) * U8F(gp.x, 0), bfhi(pv.x) * U8F(gp.x, 1)); w.y = pk2(bflo(pv.y) * U8F(gp.x, 2), bfhi(pv.y) * U8F(gp.x, 3));
                w.z = pk2(bflo(pv.z) * U8F(gp.y, 0), bfhi(pv.z) * U8F(gp.y, 1)); w.w = pk2(bflo(pv.w) * U8F(gp.y, 2), bfhi(pv.w) * U8F(gp.y, 3));
                *(v4u*)(MX + row * DM + col) = w; }
            LDS_WAIT();
#pragma unroll
            for (int i4 = 0; i4 < NI4; ++i4) gpc[i4] = gpn[i4];
        }
    }
    __syncthreads();
    for (int sq = 0; sq < (SAMPLE ? 2 : 1); ++sq) {
    const int bs = b + sq; const size_t rowatt = SAMPLE ? rowbase + 8 * sq : rowbase;
#pragma unroll
    for (int i = 0; i < 4; ++i) {
        const int p = tid + 512 * i, row = p >> 3, c8 = p & 7;
        v4u kv = (v4u){0u, 0u, 0u, 0u}, vv = (v4u){0u, 0u, 0u, 0u};
        if (!SAMPLE) { kv = kpre[i]; vv = vpre[i]; }
        else {
            if (row < 128) { const size_t off = ((size_t)(bs * 128 + row) * 4 + h) * 64 + c8 * 8;
                const f32x4 k0 = *(const f32x4*)(ck + off), k1 = *(const f32x4*)(ck + off + 4), v0 = *(const f32x4*)(cv + off), v1 = *(const f32x4*)(cv + off + 4);
                kv = (v4u){pk2(k0.x, k0.y), pk2(k0.z, k0.w), pk2(k1.x, k1.y), pk2(k1.z, k1.w)}; vv = (v4u){pk2(v0.x, v0.y), pk2(v0.z, v0.w), pk2(v1.x, v1.y), pk2(v1.z, v1.w)}; }
            else if (row < 136) { const size_t zr_ = (size_t)(NPR + bs * 8 + row - 128); kv = *(const v4u*)(Z + zoff(zr_, KOFF + h * 64 + c8 * 8)); vv = *(const v4u*)(Z + zoff(zr_, VOFF + h * 64 + c8 * 8)); }
        }
        *(LAS v4u*)(lds + LDS_K + c8 * KCH + row * 16) = kv;
        *(LAS v4u*)(lds + LDS_V + ((row >> 4) * 2 + (c8 >> 2)) * 1024 + (row & 15) * 64 + (c8 & 3) * 16) = vv;
    }
    __syncthreads();
    const float sink2 = sinks[h * 8 + g] * 1.4426950408889634f;
    const float SC = 0.125f * 1.4426950408889634f;
    const int vlane = ((lane >> 4) & 1) * 32 + (lane & 3) * 8 + (4 * hi + ((lane & 15) >> 2)) * 64;
    constexpr int NJ4 = SAMPLE ? 1 : 4;
    const bf16* qp0 = Z + zoff(SAMPLE ? (size_t)(NPR + bs * 8 + (r32 & 7)) : (size_t)(b * 2048 + n * 128 + r32), h * 512 + g * 64 + hi * 8);
    bf16x8 qr[4], qn[4];
#pragma unroll
    for (int d0 = 0; d0 < 4; ++d0) qr[d0] = *(const bf16x8*)(qp0 + d0 * 16);
    for (int qt = 0; qt < NQT; ++qt) {
        if (qt + 1 < NQT) {
#pragma unroll
            for (int d0 = 0; d0 < 4; ++d0) qn[d0] = *(const bf16x8*)(qp0 + (size_t)(qt + 1) * 32 * 64 + d0 * 16); }
        v2u gav[NJ4]; v4u pgv[NJ4];
#pragma unroll
        for (int i4 = 0; i4 < NJ4; ++i4) { const size_t row = rowatt + qt * 32 + i4 * 8 + (lane >> 3); const int col = h * 512 + g * 64 + (lane & 7) * 8;
            gav[i4] = *(const v2u*)(G8 + g8off(row, col)); pgv[i4] = *(const v4u*)(MX + row * DM + col); }
        f32x16 p[5];
#pragma unroll
        for (int kt = 0; kt < 5; ++kt) {
            f32x16 a = {};
#pragma unroll
            for (int d0 = 0; d0 < 4; ++d0) { const bf16x8 kf = *(const LAS bf16x8*)(lds + LDS_K + (2 * d0 + hi) * KCH + (32 * (qt + kt) + r32) * 16);
                a = __builtin_amdgcn_mfma_f32_32x32x16_bf16(kf, qr[d0], a, 0, 0, 0); }
            p[kt] = a;
        }
        float mx = -3.0e38f;
#pragma unroll
        for (int kt = 0; kt < 5; ++kt) {
            const bool dead = (!SAMPLE) && (n == 0) && (qt + kt < 4);
            if (dead) {
#pragma unroll
                for (int r = 0; r < 16; ++r) p[kt][r] = -1.0e30f;
            } else {
#pragma unroll
                for (int r = 0; r < 16; ++r) { const int jj = 32 * kt + crow(r, hi);
                    if (kt == 0) p[kt][r] = (jj > r32) ? p[kt][r] : -1.0e30f;
                    if (kt == 4) p[kt][r] = (jj <= r32 + 128) ? p[kt][r] : -1.0e30f;
                    mx = fmaxf(mx, p[kt][r]); }
            }
        }
        mx = fmaxf(mx, __shfl_xor(mx, 32));
        const float mfin = fmaxf(mx * SC, sink2);
        float ls = 0.f;
#pragma unroll
        for (int kt = 0; kt < 5; ++kt)
#pragma unroll
            for (int r = 0; r < 16; ++r) { const float e = __builtin_amdgcn_exp2f(__builtin_fmaf(p[kt][r], SC, -mfin)); p[kt][r] = e; ls += e; }
        ls += __shfl_xor(ls, 32);
        const float l = ls + __builtin_amdgcn_exp2f(sink2 - mfin);
        f32x16 o[2]; o[0] = f32x16{}; o[1] = f32x16{};
#pragma unroll
        for (int kt = 0; kt < 5; ++kt)
#pragma unroll
            for (int c = 0; c < 2; ++c) {
                v4u pw; pw.x = pk2(p[kt][8 * c + 0], p[kt][8 * c + 1]); pw.y = pk2(p[kt][8 * c + 2], p[kt][8 * c + 3]); pw.z = pk2(p[kt][8 * c + 4], p[kt][8 * c + 5]); pw.w = pk2(p[kt][8 * c + 6], p[kt][8 * c + 7]);
                const bf16x8 pa = __builtin_bit_cast(bf16x8, pw);
                const int kg = 2 * (qt + kt) + c;
#pragma unroll
                for (int d0 = 0; d0 < 2; ++d0) { const LAS unsigned char* vp = lds + LDS_V + (kg * 2 + d0) * 1024 + vlane;
                    const s16x4 lo = vtr(vp), hh = vtr(vp + 512);
                    const bf16x8 vf = (bf16x8){lo[0], lo[1], lo[2], lo[3], hh[0], hh[1], hh[2], hh[3]};
                    o[d0] = __builtin_amdgcn_mfma_f32_32x32x16_bf16(pa, vf, o[d0], 0, 0, 0); }
            }
        LDS_WAIT();
        if (hi == 0) wsf[r32] = l;
        LDS_WAIT();
#pragma unroll
        for (int r = 0; r < 16; ++r) { const int i = crow(r, hi); const float rl = __builtin_amdgcn_rcpf(wsf[i]);
            ost[i * OSTE + r32] = (unsigned short)f2bf(o[0][r] * rl); ost[i * OSTE + 32 + r32] = (unsigned short)f2bf(o[1][r] * rl); }
        LDS_WAIT();
#pragma unroll
        for (int i4 = 0; i4 < (SAMPLE ? 1 : 4); ++i4) { const int i = i4 * 8 + (lane >> 3), ch = lane & 7;
            const size_t row = rowatt + qt * 32 + i; const int col = h * 512 + g * 64 + ch * 8;
            const v4u av = *(const LAS v4u*)(ost + i * OSTE + ch * 8);
            const v2u ga = gav[i4];
            const v4u pg = pgv[i4];
            v4u w; w.x = pk2(bflo(pg.x) + bflo(av.x) * U8F(ga.x, 0), bfhi(pg.x) + bfhi(av.x) * U8F(ga.x, 1)); w.y = pk2(bflo(pg.y) + bflo(av.y) * U8F(ga.x, 2), bfhi(pg.y) + bfhi(av.y) * U8F(ga.x, 3));
            w.z = pk2(bflo(pg.z) + bflo(av.z) * U8F(ga.y, 0), bfhi(pg.z) + bfhi(av.z) * U8F(ga.y, 1)); w.w = pk2(bflo(pg.w) + bflo(av.w) * U8F(ga.y, 2), bfhi(pg.w) + bfhi(av.w) * U8F(ga.y, 3));
            *(v4u*)(MX + row * DM + col) = w; }
        LDS_WAIT();
#pragma unroll
        for (int d0 = 0; d0 < 4; ++d0) qr[d0] = qn[d0];
    }
    __syncthreads();
    }
}
}

__device__ __forceinline__ void grid_bar(unsigned* ctr, unsigned target) {
    asm volatile("s_waitcnt vmcnt(0) lgkmcnt(0)" ::: "memory");
    __syncthreads();
    if (threadIdx.x == 0) {
        __builtin_amdgcn_fence(__ATOMIC_RELEASE, "agent");
        asm volatile("s_waitcnt vmcnt(0)" ::: "memory");
        __hip_atomic_fetch_add(ctr, 1u, __ATOMIC_RELAXED, __HIP_MEMORY_SCOPE_AGENT);
        while (__hip_atomic_load(ctr, __ATOMIC_RELAXED, __HIP_MEMORY_SCOPE_AGENT) < target) __builtin_amdgcn_s_sleep(4);
        __builtin_amdgcn_fence(__ATOMIC_ACQUIRE, "agent");
        asm volatile("s_waitcnt vmcnt(0)" ::: "memory");
    }
    __syncthreads();
}

struct Args { const float* in[16]; float* out; unsigned char* ws; int ph_lo, ph_hi; };

__global__ void __launch_bounds__(NWAVES * 64, 2) mega_fwd(Args args) {
    extern __shared__ __attribute__((aligned(16))) unsigned char lds_raw[];
    LAS unsigned char* lds = (LAS unsigned char*)lds_raw;
    const int tid = threadIdx.x, lane = tid & 63, wave = __builtin_amdgcn_readfirstlane(tid >> 6);
    const int G = gridDim.x, bx = blockIdx.x;
    const int vcu = (G % 8 == 0) ? (bx % 8) * (G / 8) + bx / 8 : bx;
    const int gw = vcu * NWAVES + wave, NGW = G * NWAVES;
    const size_t gt = (size_t)bx * (NWAVES * 64) + tid, NGT = (size_t)G * (NWAVES * 64);
#define x_p (args.in[0])
#define x_s (args.in[1])
#define cache_k (args.in[2])
#define cache_v (args.in[3])
#define state_pool (args.in[4])
#define g_attn_pre (args.in[5])
#define g_attn_post (args.in[6])
#define w_in (args.in[7])
#define sinks (args.in[8])
#define w_pool (args.in[9])
#define pool_scale (args.in[10])
#define w_out (args.in[11])
#define g_mlp_pre (args.in[12])
#define g_mlp_post (args.in[13])
#define w_up (args.in[14])
#define w_down (args.in[15])
#define out (args.out)
#define Win_t ((bf16*)(args.ws + WS_WIN))
#define Wout_t ((bf16*)(args.ws + WS_WOUT))
#define Wup_t ((bf16*)(args.ws + WS_WUP))
#define Wdn_t ((bf16*)(args.ws + WS_WDN))
#define Wpool_t ((bf16*)(args.ws + WS_WPOOL))
#define XN ((bf16*)(args.ws + WS_XN))
#define Z ((bf16*)(args.ws + WS_R))
#define XN8 ((unsigned char*)(args.ws + WS_POOLED))
#define W8_t ((unsigned char*)(args.ws + WS_W8))
#define SPB ((float*)(args.ws + WS_SP))
#define MX XN
#define OB Z
#define HM Z
#define FB XN
    const int lo = args.ph_lo, hi = args.ph_hi;
    if (blockIdx.x == 0 && threadIdx.x < 16 && lo == 0 && hi > 1)
        __hip_atomic_store((unsigned*)args.ws + 64 * threadIdx.x, 0u, __ATOMIC_RELAXED, __HIP_MEMORY_SCOPE_AGENT);
#ifdef ONLY_PHASE
#define IN(k) ((k) == ONLY_PHASE && lo <= (k) && (k) < hi)
#else
#define IN(k) (lo <= (k) && (k) < hi)
#endif
#define SEAM(k) do { if ((k) != 3 && IN(k) && IN((k) + 1)) { if ((k) == 0) cg::this_grid().sync(); else { grid_bar((unsigned*)args.ws + 64 * (k), (unsigned)G); if (PROBE_DBLBAR) grid_bar((unsigned*)args.ws + 64 * ((k) + 16), (unsigned)G); } } } while (0)

    for (int rep_ = 0; rep_ < ((PROBE_REPEAT_MASK >> 0) & 1) + 1; ++rep_)
    if (IN(0)) {
        LAS float* scr = (LAS float*)(lds + wave * 16384);
        constexpr int I_IN = (DM / 64) * (DIN / 32), I_OUT = (DM / 64) * (DM / 32), I_UP = (DM / 64) * (DFF / 32), I_DN = (DFF / 64) * (DM / 32), I_PG = (256 / 64) * (512 / 32);
        constexpr int NITEMS = I_IN + I_OUT + I_UP + I_DN + 4 * I_PG;
        constexpr int NLATE = I_OUT + I_UP + I_DN + 4 * I_PG;
        for (int it = gw; it < NLATE; it += NGW) {
            int r = it;
            if (r < I_OUT) { p0_transpose_item<true>(w_out, DM, DM, Wout_t, 0, scr, r, lane); continue; } r -= I_OUT;
            if (r < I_UP) { p0_transpose_item<true>(w_up, DM, DFF, Wup_t, 0, scr, r, lane); continue; } r -= I_UP;
            if (r < I_DN) { p0_transpose_item<true>(w_down, DFF, DM, Wdn_t, 0, scr, r, lane); continue; } r -= I_DN;
            const int gi = r / I_PG; p0_transpose_item(w_pool + (size_t)gi * 256 * 512, 256, 512, Wpool_t, gi * 512, scr, r % I_PG, lane);
        }
        {
            __syncthreads();
            LAS f32x4* gl1 = (LAS f32x4*)lds; gl1[tid] = ((const f32x4*)g_attn_pre)[tid];
            __syncthreads();
#define P0_XROW(m_) ((const f32x4*)((m_) < NPR ? x_p + (size_t)(m_) * DM : x_s + (size_t)((m_) - NPR) * DM) + lane)
            f32x4 xa[8];
            if (gw < MROWS) { const f32x4* xr_ = P0_XROW(gw);
#pragma unroll
                for (int j = 0; j < 8; ++j) xa[j] = __builtin_nontemporal_load(xr_ + 64 * j); }
            for (int m = gw; m < MROWS; m += NGW) {
                f32x4 xb[8]; const int mn = m + NGW;
                if (mn < MROWS) { const f32x4* xr_ = P0_XROW(mn);
#pragma unroll
                    for (int j = 0; j < 8; ++j) xb[j] = __builtin_nontemporal_load(xr_ + 64 * j); }
                float s_ = 0.f;
#pragma unroll
                for (int j = 0; j < 8; ++j) s_ += (xa[j].x * xa[j].x + xa[j].y * xa[j].y) + (xa[j].z * xa[j].z + xa[j].w * xa[j].w);
                const float r_ = 1.0f / sqrtf(wave_sum(s_) * (1.f / DM) + EPS); v2u* o8_ = (v2u*)(XN + (size_t)m * DM) + lane; int lq_ = lane; asm volatile("" : "+v"(lq_));
#pragma unroll
                for (int j = 0; j < 8; ++j) { const f32x4 gg = gl1[lq_ + 64 * j]; const f32x4 hv = xa[j] * r_ * gg; v2u w; w.x = pk2(hv.x, hv.y); w.y = pk2(hv.z, hv.w); o8_[64 * j] = w;
                    ((unsigned*)(XN8 + (size_t)m * DM))[lq_ + 64 * j] = pk4_fp8(hv.x, hv.y, hv.z, hv.w); }
#pragma unroll
                for (int j = 0; j < 8; ++j) xa[j] = xb[j];
            }
#undef P0_XROW
            __syncthreads();
        }
        for (int r = gw; r < I_IN; r += NGW) {
            if (r % (DIN / 32) < NBF / 32) p0_transpose_item(w_in, DM, DIN, Win_t, 0, scr, r, lane); else p0_transpose_item_f8(w_in, DM, DIN, W8_t, NBF, 32.0f, scr, r, lane);
        }
    }
    SEAM(0);
    for (int rep_ = 0; rep_ < ((PROBE_REPEAT_MASK >> 1) & 1) + 1; ++rep_)
    if (IN(1)) {
        constexpr int NU8 = (MROWS / 256) * (NF8 / 256), NUB = (MROWS / 256) * (NBF / 256);
        {   pg8::Gemm g{(const pg8::bf16_t*)XN8, (const pg8::bf16_t*)W8_t, MROWS, NF8, DM / 2, DM / 2, DM / 2, 0, 0};
            pg8::StaticOrder S; S.init(MROWS, NF8, G, bx);
            pg8::EpiGate8 E{(unsigned char*)Z + G8_BYTE_OFF, 1.0f / 32.0f};
            pg8::gemm_phase<pg8::EpiGate8, false, -1, true>(lds, g, S, E); }
        {   pg8::Gemm g{XN, Win_t, MROWS, NBF, DM, DM, DM, 0, 0}; pg8::StaticOrder S; S.init(MROWS, NBF, G, bx);
            S.base = ((NU8 - bx + G - 1) / G) * G - NU8; S.limit = NUB;
            pg8::EpiBf16<0> E{Z, DIN, nullptr, 0, 1.0f, 0};
            pg8::gemm_phase<pg8::EpiBf16<0>>(lds, g, S, E); }
    }
    SEAM(1);
    for (int rep_ = 0; rep_ < ((PROBE_REPEAT_MASK >> 2) & 1) + 1; ++rep_)
    if (IN(2)) {
        {
            constexpr size_t N_KP = 65536, N_PP = 30720, N_KS = 1048576, N_PS = 491520;
            constexpr size_t T0 = N_KP, T1 = T0 + N_KP, T2 = T1 + N_PP, T3 = T2 + N_KS, T4 = T3 + N_KS, T5 = T4 + N_PS;
            for (int rB_ = 0; rB_ < PROBE_P2B; ++rB_)
            for (size_t it0 = gt; it0 < T5; it0 += 8 * NGT) {
                f32x4 vv[8]; float* dd[8];
#pragma unroll
                for (int k4 = 0; k4 < 8; ++k4) { const size_t it = it0 + (size_t)k4 * NGT; f32x4 v = (f32x4){0.f, 0.f, 0.f, 0.f}; float* dst = nullptr; if (it < T5) {
                if (it < T1) { const bool isv = it >= T0; const size_t e = (isv ? it - T0 : it) * 4; const int c = (int)(e & 255), j = (int)((e >> 8) & 127), b = (int)(e >> 15);
                    const v2u z = *(const v2u*)(Z + zoff((size_t)(b * 2048 + 1920 + j), (isv ? VOFF : KOFF) + c)); v = (f32x4){bflo(z.x), bfhi(z.x), bflo(z.y), bfhi(z.y)}; dst = out + (isv ? O_VP : O_KP) + e; }
                else if (it < T2) { const size_t e = (it - T1) * 4; const int c = (int)(e & 1023), r = (int)((e >> 10) % 15), b = (int)((e >> 10) / 15);
                    const v2u z = *(const v2u*)(Z + zoff((size_t)(b * 2048 + 2033 + r), UOFF + c)); v = (f32x4){bflo(z.x), bfhi(z.x), bflo(z.y), bfhi(z.y)}; dst = out + O_PP + e; }
                else if (it < T4) { const bool isv = it >= T3; const size_t e = (isv ? it - T3 : it - T2) * 4; const int c = (int)(e & 255), j = (int)((e >> 8) & 127), b = (int)(e >> 15);
                    if (j < 120) v = *(const f32x4*)((isv ? cache_v : cache_k) + ((size_t)b * 128 + j + 8) * 256 + c);
                    else { const v2u z = *(const v2u*)(Z + zoff((size_t)(NPR + b * 8 + j - 120), (isv ? VOFF : KOFF) + c)); v = (f32x4){bflo(z.x), bfhi(z.x), bflo(z.y), bfhi(z.y)}; }
                    dst = out + (isv ? O_VS : O_KS) + e; }
                else { const size_t e = (it - T4) * 4; const int c = (int)(e & 1023), r = (int)((e >> 10) % 15), b = (int)((e >> 10) / 15);
                    if (r < 7) v = *(const f32x4*)(state_pool + ((size_t)b * 15 + r + 8) * DPOOL + c);
                    else { const v2u z = *(const v2u*)(Z + zoff((size_t)(NPR + b * 8 + r - 7), UOFF + c)); v = (f32x4){bflo(z.x), bfhi(z.x), bflo(z.y), bfhi(z.y)}; }
                    dst = out + O_PS + e; }
                } vv[k4] = v; dd[k4] = dst; }
#pragma unroll
                for (int k4 = 0; k4 < 8; ++k4) if (dd[k4]) __builtin_nontemporal_store(vv[k4], (f32x4*)dd[k4]);
            }
        }
        for (int rC_ = 0; rC_ < PROBE_P2C; ++rC_)
        for (int u = vcu; u < 512; u += G) att::mixer_unit<false>(u >> 6, (u >> 2) & 15, u & 3, Z, cache_k, cache_v, sinks, state_pool, Wpool_t, pool_scale, MX, lds);
        for (int rD_ = 0; rD_ < PROBE_P2D; ++rD_)
        for (int u = vcu; u < 256; u += G) att::mixer_unit<true>(2 * (u >> 2), 0, u & 3, Z, cache_k, cache_v, sinks, state_pool, Wpool_t, pool_scale, MX, lds);
    }
    SEAM(2);
    if (IN(3)) {   }
    SEAM(3);
    for (int rep_ = 0; rep_ < ((PROBE_REPEAT_MASK >> 4) & 1) + 1; ++rep_)
    if (IN(4)) {
        pg8::Gemm g{MX, Wout_t, MROWS, DM, DM, DM, DM, 0, 0}; pg8::StaticOrder S; S.init(MROWS, DM, G, bx, TAILP, KSPLIT);
        pg8::EpiBf16<0> E{OB, DM, SPB, NPR};
        pg8::gemm_phase<pg8::EpiBf16<0>>(lds, g, S, E);
    }
    SEAM(4);
    for (int rep_ = 0; rep_ < ((PROBE_REPEAT_MASK >> 5) & 1) + 1; ++rep_)
    if (IN(5)) {
        LAS f32x4* gl1 = (LAS f32x4*)lds; LAS f32x4* gl2 = (LAS f32x4*)(lds + 8192);
        gl1[tid] = ((const f32x4*)g_attn_post)[tid]; gl2[tid] = ((const f32x4*)g_mlp_pre)[tid];
        __syncthreads();
#define P5_LOAD(m_, XV, OV) do { const f32x4* xr_ = (const f32x4*)(x_p + (size_t)(m_) * DM) + lane; const v2u* or_ = (const v2u*)(OB + (size_t)(m_) * DM) + lane; \
            _Pragma("unroll") for (int j = 0; j < 8; ++j) { XV[j] = __builtin_nontemporal_load(xr_ + 64 * j); OV[j] = __builtin_nontemporal_load(or_ + 64 * j); } } while (0)
#define P5_BODY(m_, XV, V) do { float s_ = 0.f; int lq_ = lane; asm volatile("" : "+v"(lq_));        \
            _Pragma("unroll") for (int j = 0; j < 8; ++j) s_ += (V[j].x * V[j].x + V[j].y * V[j].y) + (V[j].z * V[j].z + V[j].w * V[j].w); \
            const float r1_ = 1.0f / sqrtf(wave_sum(s_) * (1.f / DM) + EPS); float s2_ = 0.f; v2u* yr_ = (v2u*)(out + (size_t)(m_) * DM + DM / 2) + lane;        \
            _Pragma("unroll") for (int j = 0; j < 8; ++j) { const f32x4 gg = gl1[lq_ + 64 * j]; V[j] = XV[j] + V[j] * r1_ * gg; v2u w1_; w1_.x = pk2(V[j].x, V[j].y); w1_.y = pk2(V[j].z, V[j].w); yr_[64 * j] = w1_; s2_ += (V[j].x * V[j].x + V[j].y * V[j].y) + (V[j].z * V[j].z + V[j].w * V[j].w); } \
            const float r2_ = 1.0f / sqrtf(wave_sum(s2_) * (1.f / DM) + EPS); v2u* o8_ = (v2u*)(XN + (size_t)(m_) * DM) + lane; \
            _Pragma("unroll") for (int j = 0; j < 8; ++j) { const f32x4 gg = gl2[lq_ + 64 * j]; v2u w; w.x = pk2(V[j].x * r2_ * gg.x, V[j].y * r2_ * gg.y); w.y = pk2(V[j].z * r2_ * gg.z, V[j].w * r2_ * gg.w); o8_[64 * j] = w; } } while (0)
        {
            f32x4 xa[8]; v2u oa[8];
            if (gw < NPR) P5_LOAD(gw, xa, oa);
            for (int m = gw; m < NPR; m += NGW) {
                f32x4 xb[8]; v2u ob[8]; const int mn = m + NGW;
                if (mn < NPR) P5_LOAD(mn, xb, ob);
                f32x4 v[8];
#pragma unroll
                for (int j = 0; j < 8; ++j) v[j] = (f32x4){bflo(oa[j].x), bfhi(oa[j].x), bflo(oa[j].y), bfhi(oa[j].y)};
                P5_BODY(m, xa, v);
#pragma unroll
                for (int j = 0; j < 8; ++j) { xa[j] = xb[j]; oa[j] = ob[j]; }
            }
        }
        if ((gw & 1) == 0)
        for (int m = NPR + (gw >> 1); m < MROWS; m += (NGW >> 1)) {
            const f32x4* xr_ = (const f32x4*)(x_s + (size_t)(m - NPR) * DM) + lane; f32x4 xv[8], v[8];
#pragma unroll
            for (int j = 0; j < 8; ++j) { xv[j] = xr_[64 * j]; v[j] = (f32x4){0.f, 0.f, 0.f, 0.f}; }
            { const char* spb_ = (const char*)SPB; unsigned so_ = (unsigned)(m - NPR) * (DM * 2u) + (unsigned)lane * 8u;
#pragma unroll 2
              for (int q = 0; q < KSPLIT; ++q) {
#pragma unroll
                for (int j = 0; j < 8; ++j) { const v2u w_ = *(const v2u*)(spb_ + (so_ + (unsigned)j * 512u)); v[j] = v[j] + (f32x4){bflo(w_.x), bfhi(w_.x), bflo(w_.y), bfhi(w_.y)}; }
                so_ += 1024u * DM * 2u; } }
            P5_BODY(m, xv, v);
        }
#undef P5_LOAD
#undef P5_BODY
        __syncthreads();
    }
    SEAM(5);
    for (int rep_ = 0; rep_ < ((PROBE_REPEAT_MASK >> 6) & 1) + 1; ++rep_)
    if (IN(6)) {
        pg8::Gemm g{XN, Wup_t, MROWS, DFF, DM, DM, DM, 0, 0}; pg8::StaticOrder S; S.init(MROWS, DFF, G, bx, 0, 1, ((MROWS / 256) * (DFF / 256) / G) * G);
        pg8::EpiBf16<2> E{HM, DFF, nullptr, 0};
        S.limit = S.hs0; pg8::gemm_phase<pg8::EpiBf16<2>>(lds, g, S, E);
        S.base = S.hs0; S.limit = S.nwg;
        if (((S.base + bx) & 1) == 0) pg8::gemm_phase<pg8::EpiBf16<2>, true, 0>(lds, g, S, E); else pg8::gemm_phase<pg8::EpiBf16<2>, true, 1>(lds, g, S, E);
    }
    SEAM(6);
    for (int rep_ = 0; rep_ < ((PROBE_REPEAT_MASK >> 7) & 1) + 1; ++rep_)
    if (IN(7)) {
        pg8::Gemm g{HM, Wdn_t, MROWS, DM, DFF, DFF, DFF, 0, 0}; pg8::StaticOrder S; S.init(MROWS, DM, G, bx, TAILP, KSPLIT);
        pg8::EpiBf16<0> E{FB, DM, SPB, NPR};
        pg8::gemm_phase<pg8::EpiBf16<0>>(lds, g, S, E);
    }
    SEAM(7);
    if (IN(8)) {
        LAS f32x4* gl1 = (LAS f32x4*)lds;
        gl1[tid] = ((const f32x4*)g_mlp_post)[tid];
        __syncthreads();
#define P8_LOAD(m_, YV, FV) do { const v2u* yr_ = (const v2u*)(out + (size_t)(m_) * DM + DM / 2) + lane; const v2u* fr_ = (const v2u*)(FB + (size_t)(m_) * DM) + lane; \
            _Pragma("unroll") for (int j = 0; j < 8; ++j) { YV[j] = __builtin_nontemporal_load(yr_ + 64 * j); FV[j] = __builtin_nontemporal_load(fr_ + 64 * j); } } while (0)
#define P8_BODY(m_, YV, V) do { float s_ = 0.f; int lq_ = lane; asm volatile("" : "+v"(lq_)); \
            _Pragma("unroll") for (int j = 0; j < 8; ++j) s_ += (V[j].x * V[j].x + V[j].y * V[j].y) + (V[j].z * V[j].z + V[j].w * V[j].w); \
            const float r1_ = 1.0f / sqrtf(wave_sum(s_) * (1.f / DM) + EPS); f32x4* yw_ = (f32x4*)(out + (size_t)(m_) * DM) + lane; \
            _Pragma("unroll") for (int j = 0; j < 8; ++j) { const f32x4 gg = gl1[lq_ + 64 * j]; const f32x4 x1_ = (f32x4){bflo(YV[j].x), bfhi(YV[j].x), bflo(YV[j].y), bfhi(YV[j].y)}; __builtin_nontemporal_store(x1_ + V[j] * r1_ * gg, yw_ + 64 * j); } } while (0)
        {
            v2u ya[8]; v2u fa[8];
            if (gw < NPR) P8_LOAD(gw, ya, fa);
            for (int m = gw; m < NPR; m += NGW) {
                v2u yb[8]; v2u fb[8]; const int mn = m + NGW;
                if (mn < NPR) P8_LOAD(mn, yb, fb);
                f32x4 v[8];
#pragma unroll
                for (int j = 0; j < 8; ++j) v[j] = (f32x4){bflo(fa[j].x), bfhi(fa[j].x), bflo(fa[j].y), bfhi(fa[j].y)};
                P8_BODY(m, ya, v);
#pragma unroll
                for (int j = 0; j < 8; ++j) { ya[j] = yb[j]; fa[j] = fb[j]; }
            }
        }
        if ((gw & 1) == 0)
        for (int m = NPR + (gw >> 1); m < MROWS; m += (NGW >> 1)) {
            const v2u* yr_ = (const v2u*)(out + (size_t)m * DM + DM / 2) + lane; v2u yv[8]; f32x4 v[8];
#pragma unroll
            for (int j = 0; j < 8; ++j) { yv[j] = yr_[64 * j]; v[j] = (f32x4){0.f, 0.f, 0.f, 0.f}; }
            { const char* spb_ = (const char*)SPB; unsigned so_ = (unsigned)(m - NPR) * (DM * 2u) + (unsigned)lane * 8u;
#pragma unroll 2
              for (int q = 0; q < KSPLIT; ++q) {
#pragma unroll
                for (int j = 0; j < 8; ++j) { const v2u w_ = *(const v2u*)(spb_ + (so_ + (unsigned)j * 512u)); v[j] = v[j] + (f32x4){bflo(w_.x), bfhi(w_.x), bflo(w_.y), bfhi(w_.y)}; }
                so_ += 1024u * DM * 2u; } }
            P8_BODY(m, yv, v);
        }
#undef P8_LOAD
#undef P8_BODY
    }
#undef IN
#undef SEAM
#undef x_p
#undef x_s
#undef cache_k
#undef cache_v
#undef state_pool
#undef g_attn_pre
#undef g_attn_post
#undef w_in
#undef sinks
#undef w_pool
#undef pool_scale
#undef w_out
#undef g_mlp_pre
#undef g_mlp_post
#undef w_up
#undef w_down
#undef out
#undef Z
#undef XN
#undef MX
#undef OB
#undef HM
#undef FB
}

extern "C" void kernel_launch(void* const* d_in, const int* in_sizes, int n_in, void* d_out, int out_size, void* d_ws, size_t ws_size, hipStream_t stream) {
    static int grid = 0;
    if (grid == 0) {
        if (n_in != 16 || (size_t)out_size != O_END || ws_size < WS_END) { fprintf(stderr, "kernel_launch: unexpected shapes (n_in %d out %d ws %zu)\n", n_in, out_size, ws_size); grid = -1; return; }
        int dev = 0, cus = 0, per_cu = 0;
        if (hipGetDevice(&dev) != hipSuccess || hipDeviceGetAttribute(&cus, hipDeviceAttributeMultiprocessorCount, dev) != hipSuccess) { grid = -1; return; }
        if (hipFuncSetAttribute((const void*)mega_fwd, hipFuncAttributeMaxDynamicSharedMemorySize, LDS_BYTES) != hipSuccess) { fprintf(stderr, "kernel_launch: hipFuncSetAttribute failed\n"); grid = -1; return; }
        if (hipOccupancyMaxActiveBlocksPerMultiprocessor(&per_cu, (const void*)mega_fwd, NWAVES * 64, LDS_BYTES) != hipSuccess || per_cu < 1) { fprintf(stderr, "kernel_launch: occupancy query says %d\n", per_cu); per_cu = 1; }
        (void)hipGetLastError();
        grid = cus;
    }
    if (grid < 0) return;
    Args a{};
    for (int i = 0; i < 16; ++i) a.in[i] = (const float*)d_in[i];
    a.out = (float*)d_out; a.ws = (unsigned char*)d_ws;
#if MK_N_LAUNCHES == 1
    a.ph_lo = 0; a.ph_hi = N_PHASES;
    void* kargs[] = {(void*)&a};
    hipError_t e = hipLaunchCooperativeKernel((const void*)mega_fwd, dim3(grid), dim3(NWAVES * 64), kargs, LDS_BYTES, stream);
    if (e != hipSuccess) fprintf(stderr, "kernel_launch: cooperative launch failed: %s (grid %d)\n", hipGetErrorString(e), grid);
#ifdef PROBE_EXTRA_PHASE
    a.ph_lo = PROBE_EXTRA_PHASE; a.ph_hi = PROBE_EXTRA_PHASE + 1;
    hipLaunchKernelGGL(mega_fwd, dim3(grid), dim3(NWAVES * 64), LDS_BYTES, stream, a);
#endif
#else
    for (int li = 0; li < N_PHASES; ++li) { a.ph_lo = li; a.ph_hi = li + 1; hipLaunchKernelGGL(mega_fwd, dim3(grid), dim3(NWAVES * 64), LDS_BYTES, stream, a); }
#endif
}
```
